# Optimizing an MI355X kernel written in HIP

```python
import math
import jax
import jax.numpy as jnp
from jax import lax
import numpy as np

D_MODEL = 1024
BATCH = 2
SEQ = 8192
DEPTH = 2

EPS = 1e-6
ROPE_THETA = 10000.0
Q_BLOCK = 128

A_HEADS = 4
A_DK = 64
A_DV = 2 * A_DK
A_QK_W = A_HEADS * 2 * A_DK
A_V_W = A_HEADS * A_DV

B_PAIRS = ((128, 1), (512, 4), (2048, 16))
B_GROUPS = len(B_PAIRS)
B_HEADS = 4
B_DH = 64
B_W = B_GROUPS * B_HEADS * B_DH
B_OUT_W = B_HEADS * B_DH

IN_SPLITS = [A_QK_W, A_QK_W, A_V_W, B_W, B_W, B_W, D_MODEL, D_MODEL]
IN_W = sum(IN_SPLITS)

N_GROUPS = 4
EXPERTS_PER_GROUP = 8
N_EXPERTS = N_GROUPS * EXPERTS_PER_GROUP
TOP_K = 2
D_EXPERT = 256

kernel_name = 'gated_hybrid_diffattn_dilated_hmoe_adaln'


def rms_norm(x, gain=None):
    xf = x.astype(jnp.float32)
    y = xf * lax.rsqrt(jnp.mean(xf * xf, axis=-1, keepdims=True) + EPS)
    if gain is not None:
        y = y * gain.astype(jnp.float32)
    return y.astype(x.dtype)


def rope_tables(positions, dim):
    inv_freq = ROPE_THETA ** (-jnp.arange(0, dim, 2, dtype=jnp.float32) / dim)
    ang = positions.astype(jnp.float32)[..., None] * inv_freq
    return jnp.cos(ang)[:, :, None, :], jnp.sin(ang)[:, :, None, :]


def apply_rope(x, cos, sin):
    xf = x.astype(jnp.float32)
    x1, x2 = jnp.split(xf, 2, axis=-1)
    out = jnp.concatenate([x1 * cos - x2 * sin, x2 * cos + x1 * sin], axis=-1)
    return out.astype(x.dtype)


def differential_attention(q, k, v, lam, lam_init, subln):
    bsz, seq = q.shape[0], q.shape[1]
    n_blocks = seq // Q_BLOCK
    q_blocks = q.reshape(bsz, n_blocks, Q_BLOCK, A_HEADS, 2, A_DK).transpose(1, 0, 2, 3, 4, 5)
    k = k.reshape(bsz, seq, A_HEADS, 2, A_DK)
    scale = A_DK ** -0.5

    def one_block(qb):
        s = jnp.einsum('bqhmd,bkhmd->bhmqk', qb, k).astype(jnp.float32) * scale
        p = jax.nn.softmax(s, axis=-1)
        a = p[:, :, 0] - lam * p[:, :, 1]
        return jnp.einsum('bhqk,bkhd->bqhd', a.astype(v.dtype), v)

    o = lax.map(one_block, q_blocks)
    o = o.transpose(1, 0, 2, 3, 4).reshape(bsz, seq, A_HEADS, A_DV)
    o = rms_norm(o, subln) * (1.0 - lam_init)
    return o.reshape(bsz, seq, A_V_W)


def dilated_window_attention(q, k, v, window, dilation):
    bsz, seq, heads, dh = q.shape
    radius = window // (2 * dilation)
    length = seq // dilation
    n = bsz * dilation

    def to_strided(t):
        return t.reshape(bsz, length, dilation, heads, dh).transpose(0, 2, 1, 3, 4).reshape(n, length, heads, dh)

    qs, ks, vs = to_strided(q), to_strided(k), to_strided(v)
    nb = -(-length // radius)
    lp = nb * radius
    qs = jnp.pad(qs, ((0, 0), (0, lp - length), (0, 0), (0, 0))).reshape(n, nb, radius, heads, dh)

    def windows(t):
        tp = jnp.pad(t, ((0, 0), (radius, lp - length + radius), (0, 0), (0, 0)))
        tp = tp.reshape(n, nb + 2, radius, heads, dh)
        return jnp.concatenate([tp[:, :-2], tp[:, 1:-1], tp[:, 2:]], axis=2)

    kw, vw = windows(ks), windows(vs)
    blk = jnp.arange(nb)[:, None] * radius
    qpos = blk + jnp.arange(radius)[None, :]
    kpos = blk - radius + jnp.arange(3 * radius)[None, :]
    rel = kpos[:, None, :] - qpos[:, :, None]
    valid = (jnp.abs(rel) <= radius) & (kpos[:, None, :] >= 0) & (kpos[:, None, :] < length)

    s = jnp.einsum('nbqhd,nbkhd->nbhqk', qs, kw).astype(jnp.float32) * (dh ** -0.5)
    s = jnp.where(valid[None, :, None], s, -jnp.inf)
    m = jnp.max(s, axis=-1, keepdims=True)
    e = jnp.exp(s - m)
    l = jnp.sum(e, axis=-1, keepdims=True)
    o = jnp.einsum('nbhqk,nbkhd->nbqhd', (e / l).astype(v.dtype), vw)
    lse = (m + jnp.log(l))[..., 0].transpose(0, 1, 3, 2)

    o = o.reshape(n, lp, heads, dh)[:, :length]
    lse = lse.reshape(n, lp, heads)[:, :length]
    o = o.reshape(bsz, dilation, length, heads, dh).transpose(0, 2, 1, 3, 4).reshape(bsz, seq, heads, dh)
    lse = lse.reshape(bsz, dilation, length, heads).transpose(0, 2, 1, 3).reshape(bsz, seq, heads)
    return o, lse


def token_mixer(h, cos, sin, lam, lam_init, w_in, qn_a, kn_a, subln_a, qn_b, kn_b, w_pa, w_pb, w_o):
    bsz, seq, _ = h.shape
    proj = h @ w_in
    cuts = [int(t) for t in np.cumsum(IN_SPLITS)[:-1]]
    qa, ka, va, qb, kb, vb, ga, gb = jnp.split(proj, cuts, axis=-1)

    qa = apply_rope(rms_norm(qa.reshape(bsz, seq, 2 * A_HEADS, A_DK), qn_a), cos, sin)
    ka = apply_rope(rms_norm(ka.reshape(bsz, seq, 2 * A_HEADS, A_DK), kn_a), cos, sin)
    va = va.reshape(bsz, seq, A_HEADS, A_DV)
    out_a = differential_attention(qa, ka, va, lam, lam_init, subln_a)

    qb = apply_rope(rms_norm(qb.reshape(bsz, seq, B_GROUPS * B_HEADS, B_DH), qn_b), cos, sin)
    kb = apply_rope(rms_norm(kb.reshape(bsz, seq, B_GROUPS * B_HEADS, B_DH), kn_b), cos, sin)
    qb = qb.reshape(bsz, seq, B_GROUPS, B_HEADS, B_DH)
    kb = kb.reshape(bsz, seq, B_GROUPS, B_HEADS, B_DH)
    vb = vb.reshape(bsz, seq, B_GROUPS, B_HEADS, B_DH)
    outs, lses = [], []
    for g, (window, dilation) in enumerate(B_PAIRS):
        o_g, lse_g = dilated_window_attention(qb[:, :, g], kb[:, :, g], vb[:, :, g], window, dilation)
        outs.append(o_g)
        lses.append(lse_g)
    wts = jax.nn.softmax(jnp.stack(lses, axis=-1), axis=-1)
    out_b = jnp.sum(jnp.stack(outs, axis=-2) * wts[..., None].astype(h.dtype), axis=-2)
    out_b = out_b.reshape(bsz, seq, B_OUT_W)

    merged = jax.nn.sigmoid(ga) * (out_a @ w_pa) + jax.nn.sigmoid(gb) * (out_b @ w_pb)
    return merged @ w_o


def hierarchical_moe(h, w_r1, b_r1, w_r2, b_r2, w_e_gate, w_e_up, w_e_down):
    bsz, seq, d = h.shape
    t = h.reshape(bsz * seq, d)
    p_group = jax.nn.softmax((t @ w_r1 + b_r1).astype(jnp.float32), axis=-1)
    g_val, g_idx = lax.top_k(p_group, 1)
    logits = (t @ w_r2 + b_r2).astype(jnp.float32).reshape(-1, N_GROUPS, EXPERTS_PER_GROUP)
    in_group = logits[jnp.arange(logits.shape[0]), g_idx[:, 0]]
    top_l, top_i = lax.top_k(in_group, TOP_K)
    weights = g_val * jax.nn.softmax(top_l, axis=-1)
    expert_id = g_idx * EXPERTS_PER_GROUP + top_i
    combine = jnp.einsum('tk,tke->te', weights,
                         jax.nn.one_hot(expert_id, N_EXPERTS, dtype=jnp.float32)).astype(h.dtype)
    y = jnp.zeros_like(t)
    for e in range(N_EXPERTS):
        hid = jax.nn.silu(t @ w_e_gate[e]) * (t @ w_e_up[e])
        y = y + combine[:, e:e + 1] * (hid @ w_e_down[e])
    return y.reshape(bsz, seq, d)


def setup_inputs(seed: int = 0) -> dict:
    key = jax.random.key(seed)
    ks = jax.random.split(key, 26)

    def dense(k, shape, fan_in, gain=1.0):
        return jax.random.normal(k, shape, jnp.float32) * (gain * fan_in ** -0.5)

    def near_one(k, shape):
        return 1.0 + 0.02 * jax.random.normal(k, shape, jnp.float32)

    def small(k, shape, s):
        return s * jax.random.normal(k, shape, jnp.float32)

    offsets = jax.random.randint(ks[2], (BATCH, 1), 0, 4096, dtype=jnp.int32)
    positions = (offsets + jnp.arange(SEQ, dtype=jnp.int32)[None, :]).astype(jnp.int32)
    return {
        'x': jax.random.normal(ks[0], (BATCH, SEQ, D_MODEL), jnp.float32),
        'c': jax.random.normal(ks[1], (BATCH, D_MODEL), jnp.float32),
        'positions': positions,
        'w_ada': dense(ks[3], (DEPTH, D_MODEL, 6 * D_MODEL), D_MODEL, 0.5),
        'b_ada': small(ks[4], (DEPTH, 6 * D_MODEL), 0.01),
        'w_in': dense(ks[5], (DEPTH, D_MODEL, IN_W), D_MODEL),
        'qn_a': near_one(ks[6], (DEPTH, A_DK)),
        'kn_a': near_one(ks[7], (DEPTH, A_DK)),
        'lam_q1': small(ks[8], (DEPTH, A_DK), 0.1),
        'lam_k1': small(ks[9], (DEPTH, A_DK), 0.1),
        'lam_q2': small(ks[10], (DEPTH, A_DK), 0.1),
        'lam_k2': small(ks[11], (DEPTH, A_DK), 0.1),
        'subln_a': near_one(ks[12], (DEPTH, A_DV)),
        'qn_b': near_one(ks[13], (DEPTH, B_DH)),
        'kn_b': near_one(ks[14], (DEPTH, B_DH)),
        'w_pa': dense(ks[15], (DEPTH, A_V_W, D_MODEL), A_V_W),
        'w_pb': dense(ks[16], (DEPTH, B_OUT_W, D_MODEL), B_OUT_W),
        'w_o': dense(ks[17], (DEPTH, D_MODEL, D_MODEL), D_MODEL),
        'w_r1': dense(ks[18], (DEPTH, D_MODEL, N_GROUPS), D_MODEL),
        'b_r1': small(ks[19], (DEPTH, N_GROUPS), 0.01),
        'w_r2': dense(ks[20], (DEPTH, D_MODEL, N_EXPERTS), D_MODEL),
        'b_r2': small(ks[21], (DEPTH, N_EXPERTS), 0.01),
        'w_e_gate': dense(ks[22], (DEPTH, N_EXPERTS, D_MODEL, D_EXPERT), D_MODEL),
        'w_e_up': dense(ks[23], (DEPTH, N_EXPERTS, D_MODEL, D_EXPERT), D_MODEL),
        'w_e_down': dense(ks[24], (DEPTH, N_EXPERTS, D_EXPERT, D_MODEL), D_EXPERT),
    }


def reference(x, c, positions, w_ada, b_ada, w_in, qn_a, kn_a, lam_q1, lam_k1, lam_q2, lam_k2,
              subln_a, qn_b, kn_b, w_pa, w_pb, w_o, w_r1, b_r1, w_r2, b_r2,
              w_e_gate, w_e_up, w_e_down):
    cos, sin = rope_tables(positions, A_DK)
    c_act = jax.nn.silu(c)
    for layer in range(DEPTH):
        mod = (c_act @ w_ada[layer] + b_ada[layer])[:, None, :]
        shift1, scale1, gate1, shift2, scale2, gate2 = jnp.split(mod, 6, axis=-1)
        lam_init = 0.8 - 0.6 * math.exp(-0.3 * layer)
        lam = (jnp.exp(jnp.sum(lam_q1[layer].astype(jnp.float32) * lam_k1[layer].astype(jnp.float32)))
               - jnp.exp(jnp.sum(lam_q2[layer].astype(jnp.float32) * lam_k2[layer].astype(jnp.float32)))
               + lam_init)

        h = rms_norm(x) * (1 + scale1) + shift1
        x = x + gate1 * token_mixer(h, cos, sin, lam, lam_init, w_in[layer], qn_a[layer], kn_a[layer],
                                    subln_a[layer], qn_b[layer], kn_b[layer],
                                    w_pa[layer], w_pb[layer], w_o[layer])

        h = rms_norm(x) * (1 + scale2) + shift2
        x = x + gate2 * hierarchical_moe(h, w_r1[layer], b_r1[layer], w_r2[layer], b_r2[layer],
                                         w_e_gate[layer], w_e_up[layer], w_e_down[layer])
    return x
```

```cpp
#include <hip/hip_runtime.h>
#include <cstdint>
#include <cstdio>
#include <cmath>

namespace nv {
constexpr int D = 1024, B = 2, S = 8192, T = B * S, DEPTH = 2;
constexpr int INW = 5888;
constexpr float EPS = 1e-6f;

__global__ void k_copy4(const float4* __restrict__ a, float4* __restrict__ o, size_t n4) {
    for (size_t i = blockIdx.x * (size_t)blockDim.x + threadIdx.x; i < n4; i += (size_t)gridDim.x * blockDim.x) o[i] = a[i];
}
__global__ void k_rope_table(const int* __restrict__ pos, float* __restrict__ cs) {
    const int i = blockIdx.x * blockDim.x + threadIdx.x;
    if (i >= T * 32) return;
    const int t = i >> 5, j = i & 31;
    const float inv = (float)pow(10000.0, -(double)(2 * j) / 64.0);
    const float ang = (float)pos[t] * inv;
    cs[(size_t)t * 64 + j] = (float)cos((double)ang);
    cs[(size_t)t * 64 + 32 + j] = (float)sin((double)ang);
}
__global__ void k_adaln(const float* __restrict__ c, const float* __restrict__ w_ada, const float* __restrict__ b_ada, float* __restrict__ mod,
                        const float* lq1, const float* lk1, const float* lq2, const float* lk2, float* __restrict__ lamv) {
    const int i = blockIdx.x * blockDim.x + threadIdx.x;
    if (i < DEPTH * B * 6 * D) {
        const int n = i % (6 * D), b = (i / (6 * D)) % B, l = i / (6 * D * B);
        const float* w = w_ada + (size_t)l * D * 6 * D + n;
        float acc = 0.f;
        for (int k = 0; k < D; ++k) { const float cv = c[b * D + k]; const float sv = cv / (1.f + expf(-cv)); acc += sv * w[(size_t)k * 6 * D]; }
        mod[i] = acc + b_ada[l * 6 * D + n];
    }
    if (i < DEPTH) {
        float s1 = 0.f, s2 = 0.f;
        for (int k = 0; k < 64; ++k) { s1 += lq1[i * 64 + k] * lk1[i * 64 + k]; s2 += lq2[i * 64 + k] * lk2[i * 64 + k]; }
        const float li = 0.8f - 0.6f * (float)exp(-0.3 * (double)i);
        lamv[i * 2] = expf(s1) - expf(s2) + li; lamv[i * 2 + 1] = li;
    }
}
__global__ void k_norm_mod(const float* __restrict__ x, const float* __restrict__ mod  , int shift_off, int scale_off, float* __restrict__ h) {
    const int t = blockIdx.x, b = t / S, tid = threadIdx.x;
    const float4 v = ((const float4*)(x + (size_t)t * D))[tid];
    float ss = v.x * v.x + v.y * v.y + v.z * v.z + v.w * v.w;
    for (int o = 32; o; o >>= 1) ss += __shfl_xor(ss, o);
    __shared__ float red[4];
    if ((tid & 63) == 0) red[tid >> 6] = ss;
    __syncthreads();
    ss = red[0] + red[1] + red[2] + red[3];
    const float r = 1.0f / sqrtf(ss * (1.0f / D) + EPS);
    const float* m = mod + (size_t)b * 6 * D;
    const float4 sc = ((const float4*)(m + scale_off))[tid], sh = ((const float4*)(m + shift_off))[tid];
    float4 o; o.x = v.x * r * (1.f + sc.x) + sh.x; o.y = v.y * r * (1.f + sc.y) + sh.y; o.z = v.z * r * (1.f + sc.z) + sh.z; o.w = v.w * r * (1.f + sc.w) + sh.w;
    ((float4*)(h + (size_t)t * D))[tid] = o;
}
__global__ void __launch_bounds__(256) k_gemm(const float* __restrict__ A, int lda, const float* __restrict__ Bm, int ldb, float* __restrict__ C, int ldc, int K) {
    __shared__ float As[16][68], Bs[16][68];
    const int tid = threadIdx.x, tx = tid & 15, ty = tid >> 4;
    const int m0 = blockIdx.y * 64, n0 = blockIdx.x * 64;
    float acc[4][4] = {};
    for (int k0 = 0; k0 < K; k0 += 16) {
        { const int r = tid >> 2, c4 = (tid & 3) * 4; const float4 v = *(const float4*)(A + (size_t)(m0 + r) * lda + k0 + c4);
          As[c4 + 0][r] = v.x; As[c4 + 1][r] = v.y; As[c4 + 2][r] = v.z; As[c4 + 3][r] = v.w; }
        { const int r = tid >> 4, c4 = (tid & 15) * 4; const float4 v = *(const float4*)(Bm + (size_t)(k0 + r) * ldb + n0 + c4);
          *(float4*)&Bs[r][c4] = v; }
        __syncthreads();
#pragma unroll
        for (int k = 0; k < 16; ++k) {
            const float4 a = *(const float4*)&As[k][ty * 4], b = *(const float4*)&Bs[k][tx * 4];
            const float av[4] = {a.x, a.y, a.z, a.w}, bv[4] = {b.x, b.y, b.z, b.w};
#pragma unroll
            for (int i = 0; i < 4; ++i)
#pragma unroll
                for (int j = 0; j < 4; ++j) acc[i][j] += av[i] * bv[j];
        }
        __syncthreads();
    }
#pragma unroll
    for (int i = 0; i < 4; ++i) *(float4*)(C + (size_t)(m0 + ty * 4 + i) * ldc + n0 + tx * 4) = make_float4(acc[i][0], acc[i][1], acc[i][2], acc[i][3]);
}
__global__ void k_qknorm_rope(float* __restrict__ P, int ld, int col0, int nheads, const float* __restrict__ gain, const float* __restrict__ cs) {
    const size_t i = blockIdx.x * (size_t)blockDim.x + threadIdx.x;
    const int j = (int)(i & 31); const size_t th = i >> 5; const int hd = (int)(th % nheads); const size_t t = th / nheads;
    if (t >= (size_t)T) return;
    float* p = P + t * ld + col0 + hd * 64;
    const float a = p[j], b = p[j + 32];
    float ss = a * a + b * b;
    for (int o = 16; o; o >>= 1) ss += __shfl_xor(ss, o);
    const float r = 1.0f / sqrtf(ss * (1.0f / 64) + EPS);
    const float x1 = a * r * gain[j], x2 = b * r * gain[j + 32];
    const float co = cs[t * 64 + j], si = cs[t * 64 + 32 + j];
    p[j] = x1 * co - x2 * si; p[j + 32] = x2 * co + x1 * si;
}
__global__ void __launch_bounds__(128) k_diffattn(const float* __restrict__ P, const float* __restrict__ lamv  , const float* __restrict__ subln, float* __restrict__ outa  ) {
    __shared__ float sm[16384];
    float* Ks = sm; float* Vs = sm + 8192;
    const int tid = threadIdx.x, r = tid & 63, m = tid >> 6, h = blockIdx.y, b = blockIdx.z;
    const size_t row = (size_t)b * S + blockIdx.x * 64 + r;
    float q[64], o[128];
#pragma unroll
    for (int d = 0; d < 64; d += 4) { const float4 v = *(const float4*)(P + row * 1536 + (2 * h + m) * 64 + d); q[d] = v.x * 0.125f; q[d + 1] = v.y * 0.125f; q[d + 2] = v.z * 0.125f; q[d + 3] = v.w * 0.125f; }
#pragma unroll
    for (int d = 0; d < 128; ++d) o[d] = 0.f;
    float mx = -INFINITY, l = 0.f;
    for (int k0 = 0; k0 < S; k0 += 64) {
        __syncthreads();
        for (int i = tid; i < 2048; i += 128) {
            const int mm = i >> 10, key = (i >> 4) & 63, c4 = (i & 15) * 4;
            *(float4*)&Ks[mm * 4096 + key * 64 + c4] = *(const float4*)(P + ((size_t)b * S + k0 + key) * 1536 + 512 + (2 * h + mm) * 64 + c4);
        }
        for (int i = tid; i < 2048; i += 128) {
            const int key = i >> 5, c4 = (i & 31) * 4;
            *(float4*)&Vs[key * 128 + c4] = *(const float4*)(P + ((size_t)b * S + k0 + key) * 1536 + 1024 + h * 128 + c4);
        }
        __syncthreads();
        for (int key = 0; key < 64; ++key) {
            const float* kp = Ks + m * 4096 + key * 64;
            float s = 0.f;
#pragma unroll
            for (int d = 0; d < 64; d += 4) { const float4 kv = *(const float4*)(kp + d); s += q[d] * kv.x + q[d + 1] * kv.y + q[d + 2] * kv.z + q[d + 3] * kv.w; }
            if (s > mx) { const float f = __expf(mx - s); l *= f;
#pragma unroll
                for (int d = 0; d < 128; ++d) o[d] *= f;
                mx = s; }
            const float p = __expf(s - mx); l += p;
            const float* vp = Vs + key * 128;
#pragma unroll
            for (int d = 0; d < 128; d += 4) { const float4 vv = *(const float4*)(vp + d); o[d] += p * vv.x; o[d + 1] += p * vv.y; o[d + 2] += p * vv.z; o[d + 3] += p * vv.w; }
        }
    }
    __syncthreads();
    const float il = 1.0f / l;
#pragma unroll
    for (int d = 0; d < 128; ++d) sm[(r * 2 + m) * 128 + d] = o[d] * il;
    __syncthreads();
    const float lam = lamv[0], li = lamv[1];
    float ss = 0.f;
    for (int d = 0; d < 128; ++d) { const float a = sm[(r * 2) * 128 + d] - lam * sm[(r * 2 + 1) * 128 + d]; ss += a * a; }
    const float rr = 1.0f / sqrtf(ss * (1.0f / 128) + EPS);
    for (int d = 64 * m; d < 64 * m + 64; ++d) { const float a = sm[(r * 2) * 128 + d] - lam * sm[(r * 2 + 1) * 128 + d];
        outa[row * 512 + h * 128 + d] = a * rr * subln[d] * (1.0f - li); }
}
__global__ void __launch_bounds__(64) k_winattn(const float* __restrict__ P, float* __restrict__ outb  ) {
    const int i = blockIdx.x * blockDim.x + threadIdx.x;
    if (i >= T * 4) return;
    const int hh = i & 3, t = i >> 2, b = t / S, pos = t % S;
    float o[64];
#pragma unroll
    for (int d = 0; d < 64; ++d) o[d] = 0.f;
    float mx = -INFINITY, l = 0.f;
    for (int g = 0; g < 3; ++g) {
        const int dil = g == 0 ? 1 : (g == 1 ? 4 : 16);
        const int hc = (g * 4 + hh) * 64;
        float q[64];
#pragma unroll
        for (int d = 0; d < 64; d += 4) { const float4 v = *(const float4*)(P + (size_t)t * 2304 + hc + d); q[d] = v.x * 0.125f; q[d + 1] = v.y * 0.125f; q[d + 2] = v.z * 0.125f; q[d + 3] = v.w * 0.125f; }
        for (int j = -64; j <= 64; ++j) {
            const int kp = pos + j * dil;
            if (kp < 0 || kp >= S) continue;
            const float* kr = P + ((size_t)b * S + kp) * 2304 + 768 + hc;
            float s = 0.f;
#pragma unroll
            for (int d = 0; d < 64; d += 4) { const float4 kv = *(const float4*)(kr + d); s += q[d] * kv.x + q[d + 1] * kv.y + q[d + 2] * kv.z + q[d + 3] * kv.w; }
            if (s > mx) { const float f = __expf(mx - s); l *= f;
#pragma unroll
                for (int d = 0; d < 64; ++d) o[d] *= f;
                mx = s; }
            const float p = __expf(s - mx); l += p;
            const float* vr = kr + 768;
#pragma unroll
            for (int d = 0; d < 64; d += 4) { const float4 vv = *(const float4*)(vr + d); o[d] += p * vv.x; o[d + 1] += p * vv.y; o[d + 2] += p * vv.z; o[d + 3] += p * vv.w; }
        }
    }
    const float il = 1.0f / l;
#pragma unroll
    for (int d = 0; d < 64; d += 4) *(float4*)(outb + (size_t)t * 256 + hh * 64 + d) = make_float4(o[d] * il, o[d + 1] * il, o[d + 2] * il, o[d + 3] * il);
}
__global__ void k_merge(const float* __restrict__ G, const float* Ta, const float* __restrict__ Tb, float* mg) {
    const size_t i = blockIdx.x * (size_t)blockDim.x + threadIdx.x;
    if (i >= (size_t)T * D) return;
    const size_t t = i / D; const int c = (int)(i % D);
    const float ga = G[t * 2048 + c], gb = G[t * 2048 + 1024 + c];
    mg[i] = Ta[i] / (1.f + expf(-ga)) + Tb[i] / (1.f + expf(-gb));
}
__global__ void k_resid(float* __restrict__ x, const float* __restrict__ mod, int gate_off, const float* __restrict__ y) {
    const size_t i = blockIdx.x * (size_t)blockDim.x + threadIdx.x;
    if (i >= (size_t)T * D) return;
    const size_t t = i / D; const int c = (int)(i % D); const int b = (int)(t / S);
    x[i] += mod[(size_t)b * 6 * D + gate_off + c] * y[i];
}
__global__ void __launch_bounds__(256) k_moe(const float* __restrict__ h2, float* __restrict__ x, const float* __restrict__ mod, int gate_off,
                                             const float* __restrict__ wr1, const float* __restrict__ br1, const float* __restrict__ wr2, const float* __restrict__ br2,
                                             const float* __restrict__ wg, const float* __restrict__ wu, const float* __restrict__ wd) {
    __shared__ float hs[1024]; __shared__ float lg[36]; __shared__ float hid[256]; __shared__ int eid[2]; __shared__ float ew[2];
    const int t = blockIdx.x, tid = threadIdx.x, b = t / S;
    ((float4*)hs)[tid] = ((const float4*)(h2 + (size_t)t * D))[tid];
    __syncthreads();
    { const int w = tid >> 6, lane = tid & 63;
      for (int o = w * 9; o < w * 9 + 9; ++o) {
          float acc = 0.f;
          for (int k = lane; k < D; k += 64) acc += hs[k] * (o < 4 ? wr1[k * 4 + o] : wr2[k * 32 + (o - 4)]);
          for (int s = 32; s; s >>= 1) acc += __shfl_xor(acc, s);
          if (lane == 0) lg[o] = acc + (o < 4 ? br1[o] : br2[o - 4]);
      } }
    __syncthreads();
    if (tid == 0) {
        float m = lg[0]; for (int g = 1; g < 4; ++g) m = fmaxf(m, lg[g]);
        float p[4], sum = 0.f; for (int g = 0; g < 4; ++g) { p[g] = expf(lg[g] - m); sum += p[g]; }
        int gi = 0; for (int g = 1; g < 4; ++g) if (p[g] / sum > p[gi] / sum) gi = g;
        const float gval = p[gi] / sum;
        const float* ig = lg + 4 + gi * 8;
        int i0 = 0; for (int e = 1; e < 8; ++e) if (ig[e] > ig[i0]) i0 = e;
        int i1 = (i0 == 0) ? 1 : 0; for (int e = 0; e < 8; ++e) if (e != i0 && ig[e] > ig[i1]) i1 = e;
        const float e1 = expf(ig[i1] - ig[i0]);
        ew[0] = gval / (1.f + e1); ew[1] = gval * e1 / (1.f + e1);
        eid[0] = gi * 8 + i0; eid[1] = gi * 8 + i1;
    }
    __syncthreads();
    float yacc[4] = {0.f, 0.f, 0.f, 0.f};
    for (int k = 0; k < 2; ++k) {
        const int e = eid[k]; const float w = ew[k];
        const float* g = wg + (size_t)e * D * 256 + tid; const float* u = wu + (size_t)e * D * 256 + tid;
        float ag = 0.f, au = 0.f;
        for (int i = 0; i < D; ++i) { const float hv = hs[i]; ag += hv * g[(size_t)i * 256]; au += hv * u[(size_t)i * 256]; }
        __syncthreads();
        hid[tid] = ag / (1.f + expf(-ag)) * au;
        __syncthreads();
        const float* dn = wd + (size_t)e * 256 * D;
        float y[4] = {0.f, 0.f, 0.f, 0.f};
        for (int j = 0; j < 256; ++j) { const float hv = hid[j];
#pragma unroll
            for (int q = 0; q < 4; ++q) y[q] += hv * dn[(size_t)j * D + tid + 256 * q]; }
#pragma unroll
        for (int q = 0; q < 4; ++q) yacc[q] += w * y[q];
    }
#pragma unroll
    for (int q = 0; q < 4; ++q) { const int c = tid + 256 * q; x[(size_t)t * D + c] += mod[(size_t)b * 6 * D + gate_off + c] * yacc[q]; }
}
}

extern "C" void kernel_launch(void* const* d_in, const int* in_sizes, int n_in, void* d_out, int out_size, void* d_ws, size_t ws_size, hipStream_t stream) {
    using namespace nv;
    const float* x = (const float*)d_in[0]; const float* c = (const float*)d_in[1]; const int* pos = (const int*)d_in[2];
    const float* w_ada = (const float*)d_in[3]; const float* b_ada = (const float*)d_in[4]; const float* w_in = (const float*)d_in[5];
    const float* qn_a = (const float*)d_in[6]; const float* kn_a = (const float*)d_in[7];
    const float* lq1 = (const float*)d_in[8]; const float* lk1 = (const float*)d_in[9]; const float* lq2 = (const float*)d_in[10]; const float* lk2 = (const float*)d_in[11];
    const float* subln = (const float*)d_in[12]; const float* qn_b = (const float*)d_in[13]; const float* kn_b = (const float*)d_in[14];
    const float* w_pa = (const float*)d_in[15]; const float* w_pb = (const float*)d_in[16]; const float* w_o = (const float*)d_in[17];
    const float* w_r1 = (const float*)d_in[18]; const float* b_r1 = (const float*)d_in[19]; const float* w_r2 = (const float*)d_in[20]; const float* b_r2 = (const float*)d_in[21];
    const float* w_g = (const float*)d_in[22]; const float* w_u = (const float*)d_in[23]; const float* w_d = (const float*)d_in[24];
    float* X = (float*)d_out;
    float* ws = (float*)d_ws; size_t off = 0;
    auto carve = [&](size_t n) { float* p = ws + off; off += (n + 63) & ~(size_t)63; return p; };
    float* cs = carve((size_t)T * 64);
    float* mod = carve((size_t)DEPTH * B * 6 * D);
    float* lamv = carve(64);
    float* H = carve((size_t)T * D);
    float* Pb = carve((size_t)T * 2304);
    float* outa = carve((size_t)T * 512);
    float* outb = carve((size_t)T * 256);
    float* MG = carve((size_t)T * D);
    if (off * sizeof(float) > ws_size) { fprintf(stderr, "workspace too small: need %zu have %zu\n", off * sizeof(float), ws_size); return; }

    k_copy4<<<2048, 256, 0, stream>>>((const float4*)x, (float4*)X, (size_t)T * D / 4);
    k_rope_table<<<(T * 32 + 255) / 256, 256, 0, stream>>>(pos, cs);
    k_adaln<<<(DEPTH * B * 6 * D + 255) / 256, 256, 0, stream>>>(c, w_ada, b_ada, mod, lq1, lk1, lq2, lk2, lamv);
    for (int l = 0; l < DEPTH; ++l) {
        const float* modl = mod + (size_t)l * B * 6 * D;
        const float* win = w_in + (size_t)l * D * INW;
        k_norm_mod<<<T, 256, 0, stream>>>(X, modl, 0, 1024, H);
        k_gemm<<<dim3(1536 / 64, T / 64), 256, 0, stream>>>(H, D, win, INW, Pb, 1536, D);
        k_qknorm_rope<<<(T * 8 * 32) / 256, 256, 0, stream>>>(Pb, 1536, 0, 8, qn_a + l * 64, cs);
        k_qknorm_rope<<<(T * 8 * 32) / 256, 256, 0, stream>>>(Pb, 1536, 512, 8, kn_a + l * 64, cs);
        k_diffattn<<<dim3(S / 64, 4, B), 128, 0, stream>>>(Pb, lamv + l * 2, subln + l * 128, outa);
        k_gemm<<<dim3(2304 / 64, T / 64), 256, 0, stream>>>(H, D, win + 1536, INW, Pb, 2304, D);
        k_qknorm_rope<<<(T * 12 * 32) / 256, 256, 0, stream>>>(Pb, 2304, 0, 12, qn_b + l * 64, cs);
        k_qknorm_rope<<<(T * 12 * 32) / 256, 256, 0, stream>>>(Pb, 2304, 768, 12, kn_b + l * 64, cs);
        k_winattn<<<(T * 4) / 64, 64, 0, stream>>>(Pb, outb);
        k_gemm<<<dim3(2048 / 64, T / 64), 256, 0, stream>>>(H, D, win + 3840, INW, Pb, 2048, D);
        k_gemm<<<dim3(D / 64, T / 64), 256, 0, stream>>>(outa, 512, w_pa + (size_t)l * 512 * D, D, MG, D, 512);
        k_gemm<<<dim3(D / 64, T / 64), 256, 0, stream>>>(outb, 256, w_pb + (size_t)l * 256 * D, D, H, D, 256);
        k_merge<<<(T * D) / 256, 256, 0, stream>>>(Pb, MG, H, MG);
        k_gemm<<<dim3(D / 64, T / 64), 256, 0, stream>>>(MG, D, w_o + (size_t)l * D * D, D, H, D, D);
        k_resid<<<(T * D) / 256, 256, 0, stream>>>(X, modl, 2048, H);
        k_norm_mod<<<T, 256, 0, stream>>>(X, modl, 3072, 4096, H);
        k_moe<<<T, 256, 0, stream>>>(H, X, modl, 5120, w_r1 + (size_t)l * D * 4, b_r1 + l * 4, w_r2 + (size_t)l * D * 32, b_r2 + l * 32,
                                     w_g + (size_t)l * 32 * D * 256, w_u + (size_t)l * 32 * D * 256, w_d + (size_t)l * 32 * 256 * D);
    }
}
```

```cpp
#include <hip/hip_runtime.h>
#include <hip/hip_bf16.h>
#include <cstdint>
#include <cstdio>
#include <cmath>
namespace pg8 {
#define PG8_LAS __attribute__((address_space(3)))
typedef unsigned short bf16_t;
typedef short bf16x8 __attribute__((ext_vector_type(8)));
typedef float f32x4 __attribute__((ext_vector_type(4)));
typedef unsigned u32x4 __attribute__((ext_vector_type(4)));
constexpr int BM = 256, BK = 64, HALF = 128, HTB = HALF * BK * 2  , STAGE_BYTES = 8 * HTB, NXCD = 8, WGM = 8;

__host__ __device__ __forceinline__ int lds_byte(int r, int c) { const int st = (r >> 4) * 2 + (c >> 5), rr = r & 15, cc = c & 31, ob = rr * 64 + cc * 2; return st * 1024 + (ob ^ (((ob >> 9) & 1) << 5)); }
__host__ __device__ __forceinline__ void stage_rc(int b, int& R, int& C) { const int st = b / 1024, sb = b % 1024, swz = sb ^ (((sb >> 9) & 1) << 5); R = (st >> 1) * 16 + swz / 64; C = (st & 1) * 32 + (swz % 64) / 2; }
__host__ __device__ __forceinline__ int perm32(int rho) { const int n = rho >> 4, i = rho & 15; return 8 * (i >> 2) + 4 * n + (i & 3); }

struct Unit { int pm, pn; };
struct Gemm { const bf16_t* A; const bf16_t* Bt; int M, N, K; };

struct StaticOrder {
    int nM, nN, nwg, G, c;
    __host__ __device__ void init(int M, int N, int G_, int c_) { nM = M / BM; nN = N / BM; nwg = nM * nN; G = G_; c = c_; }
    __host__ __device__ bool next(int i, Unit& u) const {
        const long L = (long)i * G + c; if (L >= nwg) return false;
        int wgid = (int)L; { const int q = nwg / NXCD, r = nwg % NXCD, xcd = wgid % NXCD, off = wgid / NXCD; wgid = (xcd < r ? xcd * (q + 1) : r * (q + 1) + (xcd - r) * q) + off; }
        const int nig = WGM * nN, gid = wgid / nig, fm = gid * WGM, gsz = (nM - fm) < WGM ? (nM - fm) : WGM;
        u.pm = fm + ((wgid % nig) % gsz); u.pn = (wgid % nig) / gsz; return true;
    }
    __device__ __forceinline__ void a_ready(const Unit&) const {}
    __device__ __forceinline__ void done(const Unit&) const {}
};

__device__ __forceinline__ unsigned cvt_pk_bf16(float lo, float hi) { unsigned r; asm volatile("v_cvt_pk_bf16_f32 %0, %1, %2" : "=v"(r) : "v"(lo), "v"(hi)); return r; }
typedef float f32x2 __attribute__((ext_vector_type(2)));
template <class Epi, class Sched, bool ALIGN_EPI = false, bool SP2 = false>
__device__ __forceinline__ void gemm_phase(PG8_LAS unsigned char* lds, const Gemm g, const Sched& S, const Epi& E, const int wid_arg) {
    int lane_; asm volatile("v_mbcnt_lo_u32_b32 %0, -1, 0\n\tv_mbcnt_hi_u32_b32 %0, -1, %0" : "=v"(lane_));
    const int wid = wid_arg, lane = lane_, tid = wid * 64 + lane, wr = wid >> 2, wc = wid & 3, fr = lane & 15, fq = lane >> 4;
    const int K = g.K, nt = K / BK;
    unsigned voffA[2], voffB[2];
#pragma unroll
    for (int i = 0; i < 2; ++i) { int R, C; stage_rc(tid * 16 + i * 8192, R, C); const int Rb = Epi::PERM ? ((R & ~31) + perm32(R & 31)) : R;
        voffA[i] = (unsigned)(R * K + C) * 2u; voffB[i] = (unsigned)(Rb * K + C) * 2u; }
    const size_t kstep = (size_t)(BK * 2);
    const size_t hstep = (size_t)HALF * K * 2;
    const size_t tstep = 2 * hstep;
    const unsigned ldsw = (unsigned)wid * 1024u;
    const int aoff = lds_byte(wr * 64 + fr, fq * 8), boff = lds_byte(wc * 32 + fr, fq * 8);
#define PG8_SA(b, h) (((b) * 2 + (h)) * HTB)
#define PG8_SB(b, h) ((4 + (b) * 2 + (h)) * HTB)
#define PG8_STAGE(bufoff, gbase, voff) do { _Pragma("unroll") for (int _i = 0; _i < 2; ++_i) \
        __builtin_amdgcn_global_load_lds((const unsigned*)((const char*)(gbase) + (voff)[_i]), (PG8_LAS unsigned*)(lds + (bufoff) + ldsw + _i * 8192), 16, 0, 0); } while (0)
#define PG8_LDA(dst, b, h) do { _Pragma("unroll") for (int m = 0; m < 4; ++m) _Pragma("unroll") for (int k = 0; k < 2; ++k) dst[m][k] = *(const PG8_LAS bf16x8*)(lds + PG8_SA(b, h) + aoff + m * 2048 + k * 1024); } while (0)
#define PG8_LDB(dst, b, h) do { _Pragma("unroll") for (int n = 0; n < 2; ++n) _Pragma("unroll") for (int k = 0; k < 2; ++k) dst[n][k] = *(const PG8_LAS bf16x8*)(lds + PG8_SB(b, h) + boff + n * 2048 + k * 1024); } while (0)
#define PG8_MMA(ai, bj, At, Bt) do { __builtin_amdgcn_s_setprio(1); _Pragma("unroll") for (int m = 0; m < 4; ++m) _Pragma("unroll") for (int n = 0; n < 2; ++n) _Pragma("unroll") for (int k = 0; k < 2; ++k) \
        acc[ai][bj][m][n] = __builtin_amdgcn_mfma_f32_16x16x32_bf16(Bt[n][k], At[m][k], acc[ai][bj][m][n], 0, 0, 0); __builtin_amdgcn_s_setprio(0); } while (0)
#define PG8_WAIT_V(n) asm volatile("s_waitcnt vmcnt(" #n ")" ::: "memory")
#define PG8_WAIT_L(n) asm volatile("s_waitcnt lgkmcnt(" #n ")" ::: "memory")
#define PG8_BAR __builtin_amdgcn_s_barrier()
#define PG8_SCHED __builtin_amdgcn_sched_barrier(0)
    Unit cur, nxt; int ui = 0;
    if (!S.next(0, cur)) return;
    f32x4 acc[2][2][4][2];
#pragma unroll
    for (int a = 0; a < 2; ++a)
#pragma unroll
        for (int b = 0; b < 2; ++b)
#pragma unroll
            for (int m = 0; m < 4; ++m)
#pragma unroll
                for (int n = 0; n < 2; ++n) acc[a][b][m][n] = (f32x4){0.f, 0.f, 0.f, 0.f};
    bf16x8 At[4][2], B0[2][2], B1[2][2];
    const char* cA = (const char*)g.A + (size_t)cur.pm * tstep; const char* cB = (const char*)g.Bt + (size_t)cur.pn * tstep;
    S.a_ready(cur);
    if constexpr (SP2) {
        PG8_STAGE(PG8_SB(0, 0), cB, voffB); PG8_STAGE(PG8_SB(0, 1), cB + hstep, voffB); PG8_STAGE(PG8_SA(0, 0), cA, voffA); PG8_STAGE(PG8_SA(0, 1), cA + hstep, voffA);
        if (wr == 1) PG8_BAR;
        PG8_WAIT_V(2); PG8_BAR;
        PG8_STAGE(PG8_SB(1, 0), cB + kstep, voffB); PG8_STAGE(PG8_SA(1, 0), cA + kstep, voffA); PG8_STAGE(PG8_SB(1, 1), cB + hstep + kstep, voffB);
        PG8_WAIT_V(6); PG8_BAR;
    } else {
        PG8_STAGE(PG8_SB(0, 0), cB, voffB); PG8_STAGE(PG8_SA(0, 0), cA, voffA); PG8_STAGE(PG8_SB(0, 1), cB + hstep, voffB); PG8_STAGE(PG8_SA(0, 1), cA + hstep, voffA);
        if (wr == 1) PG8_BAR;
        PG8_WAIT_V(4); PG8_BAR;
        PG8_STAGE(PG8_SB(1, 0), cB + kstep, voffB); PG8_STAGE(PG8_SA(1, 0), cA + kstep, voffA); PG8_STAGE(PG8_SB(1, 1), cB + hstep + kstep, voffB);
        PG8_WAIT_V(6); PG8_BAR;
    }
    for (;;) {
        const bool has_next = S.next(ui + 1, nxt);
        const char* nA = has_next ? (const char*)g.A + (size_t)nxt.pm * tstep : cA; const char* nB = has_next ? (const char*)g.Bt + (size_t)nxt.pn * tstep : cB;
        for (int t = 0; t < nt; t += 2) {
            const bool last = (t == nt - 2);
            const char* a1 = cA + (size_t)(t + 1) * kstep;
            const char* a2 = last ? nA : cA + (size_t)(t + 2) * kstep; const char* b2 = last ? nB : cB + (size_t)(t + 2) * kstep;
            const char* a3 = a2 + kstep; const char* b3 = b2 + kstep;
            if (last && has_next) S.a_ready(nxt);
            if constexpr (Epi::MID_T >= 0) { if (t == Epi::MID_T) E.mid(acc, cur, wr, wc); }
            if constexpr (SP2) {
            PG8_LDB(B0, 0, 0); PG8_LDB(B1, 0, 1); PG8_SCHED; PG8_LDA(At, 0, 0); PG8_STAGE(PG8_SA(1, 1), a1 + hstep, voffA);
            PG8_WAIT_V(8); PG8_WAIT_L(0); PG8_BAR; PG8_MMA(0, 0, At, B0); PG8_MMA(0, 1, At, B1); PG8_BAR; PG8_SCHED;
            PG8_LDA(At, 0, 1); PG8_STAGE(PG8_SB(0, 0), b2, voffB); PG8_STAGE(PG8_SB(0, 1), b2 + hstep, voffB); PG8_STAGE(PG8_SA(0, 0), a2, voffA);
            PG8_WAIT_V(8); PG8_WAIT_L(0); PG8_BAR; PG8_MMA(1, 0, At, B0); PG8_MMA(1, 1, At, B1); PG8_BAR; PG8_SCHED;
            PG8_LDB(B0, 1, 0); PG8_LDB(B1, 1, 1); PG8_SCHED; PG8_LDA(At, 1, 0); PG8_STAGE(PG8_SA(0, 1), a2 + hstep, voffA);
            PG8_WAIT_V(8); PG8_WAIT_L(0); PG8_BAR; PG8_MMA(0, 0, At, B0); PG8_MMA(0, 1, At, B1); PG8_BAR; PG8_SCHED;
            PG8_LDA(At, 1, 1); PG8_STAGE(PG8_SB(1, 0), b3, voffB); PG8_STAGE(PG8_SB(1, 1), b3 + hstep, voffB); PG8_STAGE(PG8_SA(1, 0), a3, voffA);
            PG8_WAIT_V(8); PG8_WAIT_L(0); PG8_BAR; PG8_MMA(1, 0, At, B0); PG8_MMA(1, 1, At, B1); PG8_BAR; PG8_SCHED;
            } else {
            PG8_LDB(B0, 0, 0); PG8_SCHED; PG8_LDA(At, 0, 0); PG8_STAGE(PG8_SA(1, 1), a1 + hstep, voffA);
            PG8_WAIT_L(8); PG8_BAR; PG8_WAIT_L(0); PG8_MMA(0, 0, At, B0); PG8_BAR; PG8_SCHED;
            PG8_LDB(B1, 0, 1); PG8_STAGE(PG8_SB(0, 0), b2, voffB);
            PG8_BAR; PG8_WAIT_L(0); PG8_MMA(0, 1, At, B1); PG8_BAR;
            PG8_LDA(At, 0, 1); PG8_STAGE(PG8_SA(0, 0), a2, voffA);
            PG8_BAR; PG8_WAIT_L(0); PG8_MMA(1, 0, At, B0); PG8_BAR; PG8_SCHED;
            PG8_STAGE(PG8_SB(0, 1), b2 + hstep, voffB);
            PG8_WAIT_V(6); PG8_BAR; PG8_MMA(1, 1, At, B1); PG8_BAR;
            PG8_LDB(B0, 1, 0); PG8_SCHED; PG8_LDA(At, 1, 0); PG8_STAGE(PG8_SA(0, 1), a2 + hstep, voffA);
            PG8_WAIT_L(8); PG8_BAR; PG8_WAIT_L(0); PG8_MMA(0, 0, At, B0); PG8_BAR; PG8_SCHED;
            PG8_LDB(B1, 1, 1); PG8_STAGE(PG8_SB(1, 0), b3, voffB);
            PG8_BAR; PG8_WAIT_L(0); PG8_MMA(0, 1, At, B1); PG8_BAR;
            PG8_LDA(At, 1, 1); PG8_STAGE(PG8_SA(1, 0), a3, voffA);
            PG8_BAR; PG8_WAIT_L(0); PG8_MMA(1, 0, At, B0); PG8_BAR; PG8_SCHED;
            PG8_STAGE(PG8_SB(1, 1), b3 + hstep, voffB);
            PG8_WAIT_V(6); PG8_BAR; PG8_MMA(1, 1, At, B1); PG8_BAR;
            }
        }
        if constexpr (ALIGN_EPI) { if (wr == 0) PG8_BAR; }
        if constexpr (!Epi::AFTER_DRAIN) { E(acc, cur, wr, wc, fr, fq); S.done(cur); }
        if (!has_next) break;
#pragma unroll
        for (int a = 0; a < 2; ++a)
#pragma unroll
            for (int b = 0; b < 2; ++b)
#pragma unroll
                for (int m = 0; m < 4; ++m)
#pragma unroll
                    for (int n = 0; n < 2; ++n) acc[a][b][m][n] = (f32x4){0.f, 0.f, 0.f, 0.f};
        cur = nxt; cA = nA; cB = nB; ++ui;
        if constexpr (ALIGN_EPI) { if (wr == 1) PG8_BAR; }
    }
    PG8_WAIT_V(0);
    if constexpr (!ALIGN_EPI) { if (wr == 0) PG8_BAR; }
    PG8_BAR;
    if constexpr (Epi::AFTER_DRAIN) { E.fused(acc, cur, wr, wc, fr, fq, lds, wid, lane); S.done(cur); }
#undef PG8_SA
#undef PG8_SB
#undef PG8_STAGE
#undef PG8_LDA
#undef PG8_LDB
#undef PG8_MMA
#undef PG8_WAIT_V
#undef PG8_WAIT_L
#undef PG8_BAR
#undef PG8_SCHED
}
template <class Epi, class Sched, bool ALIGN_EPI = false>
__device__ __forceinline__ void gemm_phase_g(PG8_LAS unsigned char* lds, const Gemm g, const Sched& S, const Epi& E, const int wid_arg) {
    int lane_; asm volatile("v_mbcnt_lo_u32_b32 %0, -1, 0\n\tv_mbcnt_hi_u32_b32 %0, -1, %0" : "=v"(lane_));
    const int wid = wid_arg, lane = lane_, tid = wid * 64 + lane, wr = wid >> 2, wc = wid & 3, fr = lane & 15, fq = lane >> 4;
    const int K = g.K, nt = K / BK;
    unsigned voffB[2]; int ra0, ra1; unsigned ca0, ca1;
#pragma unroll
    for (int i = 0; i < 2; ++i) { int R, C; stage_rc(tid * 16 + i * 8192, R, C); const int Rb = Epi::PERM ? ((R & ~31) + perm32(R & 31)) : R;
        if (i == 0) { ra0 = R; ca0 = (unsigned)C * 2u; } else { ra1 = R; ca1 = (unsigned)C * 2u; } voffB[i] = (unsigned)(Rb * K + C) * 2u; }
    const size_t kstep = (size_t)(BK * 2);
    const size_t hstep = (size_t)HALF * K * 2;
    const size_t tstep = 2 * hstep;
    const unsigned ldsw = (unsigned)wid * 1024u;
    const int aoff = lds_byte(wr * 64 + fr, fq * 8), boff = lds_byte(wc * 32 + fr, fq * 8);
#define PG8_SA(b, h) (((b) * 2 + (h)) * HTB)
#define PG8_SB(b, h) ((4 + (b) * 2 + (h)) * HTB)
#define PG8_STAGE(bufoff, gbase, voff) do { _Pragma("unroll") for (int _i = 0; _i < 2; ++_i) \
        __builtin_amdgcn_global_load_lds((const unsigned*)((const char*)(gbase) + (voff)[_i]), (PG8_LAS unsigned*)(lds + (bufoff) + ldsw + _i * 8192), 16, 0, 0); } while (0)
#define PG8_STAGE_G(bufoff, o0, o1, kb) do { __builtin_amdgcn_global_load_lds((const unsigned*)((const char*)g.A + (o0) + (kb)), (PG8_LAS unsigned*)(lds + (bufoff) + ldsw), 16, 0, 0); \
        __builtin_amdgcn_global_load_lds((const unsigned*)((const char*)g.A + (o1) + (kb)), (PG8_LAS unsigned*)(lds + (bufoff) + ldsw + 8192), 16, 0, 0); } while (0)
#define PG8_GOFS(U, o00, o01, o10, o11) do { o00 = (unsigned)S.a_row(U, ra0) * (unsigned)(K * 2) + ca0; o01 = (unsigned)S.a_row(U, ra1) * (unsigned)(K * 2) + ca1; \
        o10 = (unsigned)S.a_row(U, 128 + ra0) * (unsigned)(K * 2) + ca0; o11 = (unsigned)S.a_row(U, 128 + ra1) * (unsigned)(K * 2) + ca1; } while (0)
#define PG8_LDA(dst, b, h) do { _Pragma("unroll") for (int m = 0; m < 4; ++m) _Pragma("unroll") for (int k = 0; k < 2; ++k) dst[m][k] = *(const PG8_LAS bf16x8*)(lds + PG8_SA(b, h) + aoff + m * 2048 + k * 1024); } while (0)
#define PG8_LDB(dst, b, h) do { _Pragma("unroll") for (int n = 0; n < 2; ++n) _Pragma("unroll") for (int k = 0; k < 2; ++k) dst[n][k] = *(const PG8_LAS bf16x8*)(lds + PG8_SB(b, h) + boff + n * 2048 + k * 1024); } while (0)
#define PG8_MMA(ai, bj, At, Bt) do { __builtin_amdgcn_s_setprio(1); _Pragma("unroll") for (int m = 0; m < 4; ++m) _Pragma("unroll") for (int n = 0; n < 2; ++n) _Pragma("unroll") for (int k = 0; k < 2; ++k) \
        acc[ai][bj][m][n] = __builtin_amdgcn_mfma_f32_16x16x32_bf16(Bt[n][k], At[m][k], acc[ai][bj][m][n], 0, 0, 0); __builtin_amdgcn_s_setprio(0); } while (0)
#define PG8_WAIT_V(n) asm volatile("s_waitcnt vmcnt(" #n ")" ::: "memory")
#define PG8_WAIT_L(n) asm volatile("s_waitcnt lgkmcnt(" #n ")" ::: "memory")
#define PG8_BAR __builtin_amdgcn_s_barrier()
#define PG8_SCHED __builtin_amdgcn_sched_barrier(0)
    Unit cur, nxt; int ui = 0;
    if (!S.next(0, cur)) return;
    f32x4 acc[2][2][4][2];
#pragma unroll
    for (int a = 0; a < 2; ++a)
#pragma unroll
        for (int b = 0; b < 2; ++b)
#pragma unroll
            for (int m = 0; m < 4; ++m)
#pragma unroll
                for (int n = 0; n < 2; ++n) acc[a][b][m][n] = (f32x4){0.f, 0.f, 0.f, 0.f};
    bf16x8 At[4][2], B0[2][2], B1[2][2];
    const char* cB = (const char*)g.Bt + (size_t)cur.pn * tstep;
    unsigned gc00, gc01, gc10, gc11;
    PG8_GOFS(cur, gc00, gc01, gc10, gc11);
    S.a_ready(cur);
    {
        PG8_STAGE(PG8_SB(0, 0), cB, voffB); PG8_STAGE(PG8_SB(0, 1), cB + hstep, voffB); PG8_STAGE_G(PG8_SA(0, 0), gc00, gc01, 0); PG8_STAGE_G(PG8_SA(0, 1), gc10, gc11, 0);
        if (wr == 1) PG8_BAR;
        PG8_WAIT_V(2); PG8_BAR;
        PG8_STAGE(PG8_SB(1, 0), cB + kstep, voffB); PG8_STAGE_G(PG8_SA(1, 0), gc00, gc01, kstep); PG8_STAGE(PG8_SB(1, 1), cB + hstep + kstep, voffB);
        PG8_WAIT_V(6); PG8_BAR;
    }
    for (;;) {
        const bool has_next = S.next(ui + 1, nxt);
        const char* nB = has_next ? (const char*)g.Bt + (size_t)nxt.pn * tstep : cB;
        unsigned gn00 = gc00, gn01 = gc01, gn10 = gc10, gn11 = gc11;
        if (has_next) { PG8_GOFS(nxt, gn00, gn01, gn10, gn11); }
        for (int t = 0; t < nt; t += 2) {
            const bool last = (t == nt - 2);
            const char* b2 = last ? nB : cB + (size_t)(t + 2) * kstep;
            const size_t k2 = last ? (size_t)0 : (size_t)(t + 2) * kstep;
            const unsigned s00 = last ? gn00 : gc00, s01 = last ? gn01 : gc01, s10 = last ? gn10 : gc10, s11 = last ? gn11 : gc11;
            const char* b3 = b2 + kstep;
            if (last && has_next) S.a_ready(nxt);
            {
            PG8_LDB(B0, 0, 0); PG8_LDB(B1, 0, 1); PG8_SCHED; PG8_LDA(At, 0, 0); PG8_STAGE_G(PG8_SA(1, 1), gc10, gc11, (size_t)(t + 1) * kstep);
            PG8_WAIT_V(8); PG8_WAIT_L(0); PG8_BAR; PG8_MMA(0, 0, At, B0); PG8_MMA(0, 1, At, B1); PG8_BAR; PG8_SCHED;
            PG8_LDA(At, 0, 1); PG8_STAGE(PG8_SB(0, 0), b2, voffB); PG8_STAGE(PG8_SB(0, 1), b2 + hstep, voffB); PG8_STAGE_G(PG8_SA(0, 0), s00, s01, k2);
            PG8_WAIT_V(8); PG8_WAIT_L(0); PG8_BAR; PG8_MMA(1, 0, At, B0); PG8_MMA(1, 1, At, B1); PG8_BAR; PG8_SCHED;
            PG8_LDB(B0, 1, 0); PG8_LDB(B1, 1, 1); PG8_SCHED; PG8_LDA(At, 1, 0); PG8_STAGE_G(PG8_SA(0, 1), s10, s11, k2);
            PG8_WAIT_V(8); PG8_WAIT_L(0); PG8_BAR; PG8_MMA(0, 0, At, B0); PG8_MMA(0, 1, At, B1); PG8_BAR; PG8_SCHED;
            PG8_LDA(At, 1, 1); PG8_STAGE(PG8_SB(1, 0), b3, voffB); PG8_STAGE(PG8_SB(1, 1), b3 + hstep, voffB); PG8_STAGE_G(PG8_SA(1, 0), s00, s01, k2 + kstep);
            PG8_WAIT_V(8); PG8_WAIT_L(0); PG8_BAR; PG8_MMA(1, 0, At, B0); PG8_MMA(1, 1, At, B1); PG8_BAR; PG8_SCHED;
            }
        }
        if constexpr (ALIGN_EPI) { if (wr == 0) PG8_BAR; }
        if constexpr (!Epi::AFTER_DRAIN) { E(acc, cur, wr, wc, fr, fq); S.done(cur); }
        if (!has_next) break;
#pragma unroll
        for (int a = 0; a < 2; ++a)
#pragma unroll
            for (int b = 0; b < 2; ++b)
#pragma unroll
                for (int m = 0; m < 4; ++m)
#pragma unroll
                    for (int n = 0; n < 2; ++n) acc[a][b][m][n] = (f32x4){0.f, 0.f, 0.f, 0.f};
        cur = nxt; cB = nB; ++ui; gc00 = gn00; gc01 = gn01; gc10 = gn10; gc11 = gn11;
        if constexpr (ALIGN_EPI) { if (wr == 1) PG8_BAR; }
    }
    PG8_WAIT_V(0);
    if constexpr (!ALIGN_EPI) { if (wr == 0) PG8_BAR; }
    PG8_BAR;
    if constexpr (Epi::AFTER_DRAIN) { E.fused(acc, cur, wr, wc, fr, fq, lds, wid, lane); S.done(cur); }
#undef PG8_SA
#undef PG8_SB
#undef PG8_STAGE
#undef PG8_STAGE_G
#undef PG8_GOFS
#undef PG8_LDA
#undef PG8_LDB
#undef PG8_MMA
#undef PG8_WAIT_V
#undef PG8_WAIT_L
#undef PG8_BAR
#undef PG8_SCHED
}
}
namespace mk {
#define GAS __attribute__((address_space(1)))
#define LAS __attribute__((address_space(3)))
typedef unsigned short bf16;
typedef unsigned v4u __attribute__((ext_vector_type(4)));
typedef float f32x4 __attribute__((ext_vector_type(4)));
typedef short bf16x8 __attribute__((ext_vector_type(8)));
typedef GAS unsigned gu32;
typedef GAS unsigned long long gu64;
#define RLX_AGENT __ATOMIC_RELAXED, __HIP_MEMORY_SCOPE_AGENT
#define LDS_WAIT() asm volatile("s_waitcnt lgkmcnt(0)" ::: "memory")
#define VM_WAIT() asm volatile("s_waitcnt vmcnt(0)" ::: "memory")
__device__ __forceinline__ unsigned long long rt() { return __builtin_amdgcn_s_memrealtime(); }
__device__ __forceinline__ unsigned f2bf(float f) { unsigned u = __builtin_bit_cast(unsigned, f); return (u + 0x7fffu + ((u >> 16) & 1u)) >> 16; }
__device__ __forceinline__ unsigned pk2(float lo, float hi) { return f2bf(lo) | (f2bf(hi) << 16); }
#define XB_TMO      128
#define XB_XCNT(j)  (256  + 64 * (j))
#define XB_XSUB(j)  (1280 + 64 * (j))
#define XB_XGEN(j)  (2304 + 64 * (j))
#define XB_TOP      3328
#define XB_TOPGEN   3392
#define XCD_BAR_WORDS 3456
#define XB_SPIN_CAP (1u << 18)

__device__ __forceinline__ unsigned xb_ld(unsigned* p)              { return __hip_atomic_load(p, __ATOMIC_RELAXED, __HIP_MEMORY_SCOPE_AGENT); }
__device__ __forceinline__ unsigned xb_add(unsigned* p, unsigned v) { return __hip_atomic_fetch_add(p, v, __ATOMIC_RELAXED, __HIP_MEMORY_SCOPE_AGENT); }
__device__ __forceinline__ unsigned xb_xcc_id() { return (unsigned)__builtin_amdgcn_s_getreg((3 << 11) | 20) & 0xFu; }
#define XB_SPIN(cond, bar) do { unsigned _sp = 0; while (cond) { __builtin_amdgcn_s_sleep(1); \
    if ((++_sp & 255u) == 0u) { if (xb_ld(&(bar)[XB_TMO])) break; if (_sp > XB_SPIN_CAP) { atomicAdd(&(bar)[XB_TMO], 1u); break; } } } } while (0)

struct XcdBarrier {
    unsigned* bar; unsigned x;
    volatile LAS unsigned* st;
};

__device__ __forceinline__ XcdBarrier xcd_barrier_post(unsigned* bar, volatile LAS unsigned* st) {
    XcdBarrier b; b.bar = bar; b.x = xb_xcc_id(); b.st = st;
    if (threadIdx.x == 0) (void)xb_add(&bar[XB_XCNT(b.x)], 1u);
    return b;
}
__device__ __forceinline__ void xcd_barrier_complete(unsigned* bar, unsigned x, unsigned& nloc, unsigned& nx) {
    const unsigned G = gridDim.x * gridDim.y * gridDim.z;
    unsigned sum, cnt, mine, sp = 0u;
    for (;;) {
        sum = 0u; cnt = 0u; mine = 0u;
#pragma unroll
        for (unsigned j = 0; j < 16; ++j) { const unsigned c = xb_ld(&bar[XB_XCNT(j)]); sum += c; cnt += (c > 0u) ? 1u : 0u; mine = (j == x) ? c : mine; }
        if (sum == G) break;
        __builtin_amdgcn_s_sleep(1);
        if ((++sp & 255u) == 0u) { if (xb_ld(&bar[XB_TMO])) break; if (sp > XB_SPIN_CAP) { atomicAdd(&bar[XB_TMO], 1u); break; } }
    }
    nloc = mine > 0u ? mine : 1u; nx = cnt > 0u ? cnt : 1u;
}

__device__ __forceinline__ void xcd_barrier(const XcdBarrier& b) {
    asm volatile("s_waitcnt vmcnt(0)" ::: "memory");
    __syncthreads();
    if (threadIdx.x == 0) {
        unsigned* bar = b.bar;
        __builtin_amdgcn_s_waitcnt(0);
        unsigned nloc = b.st[0], nx = b.st[1];
        if (nloc == 0u) { xcd_barrier_complete(bar, b.x, nloc, nx); b.st[0] = nloc; b.st[1] = nx; }
        const unsigned old = xb_add(&bar[XB_XSUB(b.x)], 1u);
        const unsigned gen = old / nloc;
        if (old + 1u == (gen + 1u) * nloc) {
            __builtin_amdgcn_fence(__ATOMIC_RELEASE, "agent");
            asm volatile("s_waitcnt vmcnt(0)" ::: "memory");
            const unsigned og = xb_add(&bar[XB_TOP], 1u);
            const unsigned tg = og / nx;
            if (og + 1u == (tg + 1u) * nx) xb_add(&bar[XB_TOPGEN], 1u);
            else XB_SPIN(xb_ld(&bar[XB_TOPGEN]) == tg, bar);
            __builtin_amdgcn_fence(__ATOMIC_ACQUIRE, "agent");
            xb_add(&bar[XB_XGEN(b.x)], 1u);
            asm volatile("s_waitcnt vmcnt(0)" ::: "memory");
        } else {
            XB_SPIN(xb_ld(&bar[XB_XGEN(b.x)]) == gen, bar);
            __builtin_amdgcn_fence(__ATOMIC_ACQUIRE, "agent");
            asm volatile("s_waitcnt vmcnt(0)" ::: "memory");
        }
    }
    __syncthreads();
}
}
namespace mk {
constexpr int NWAVES = 8, NTHR = 512;
constexpr int D = 1024, NB = 2, S = 8192, T = NB * S, DEPTH = 2, INW = 5888, NEXP = 32, DEXP = 256;
constexpr float EPS = 1e-6f;
constexpr float C2 = 0.125f * 1.4426950408889634f;
constexpr size_t MiB = 1u << 20;
constexpr size_t WS_CTL = 0, CTL_ZERO_BYTES = 1 * MiB;
constexpr size_t WS_MOD = 1 * MiB;
constexpr size_t WS_CS = 2 * MiB;
constexpr size_t WS_WIN = 6 * MiB;
constexpr size_t WS_WPAB = 18 * MiB;
constexpr size_t WS_WO = 20 * MiB;
constexpr size_t WS_WGU = 22 * MiB;
constexpr size_t WS_WDN = 54 * MiB;
constexpr size_t WS_H = 70 * MiB;
constexpr size_t WS_QA = 102 * MiB, WS_KA = 118 * MiB, WS_VA = 134 * MiB;
constexpr size_t WS_QB = 150 * MiB, WS_KB = 174 * MiB, WS_VB = 198 * MiB;
constexpr size_t WS_GA = 222 * MiB, WS_GB = 254 * MiB;
constexpr size_t WS_OUTAB = 286 * MiB;
constexpr size_t WS_LIST = 310 * MiB;
constexpr size_t WS_RTW = 312 * MiB;
constexpr size_t WS_END = 313 * MiB;
constexpr size_t WS_HID = WS_VA;
constexpr size_t WS_Y = WS_KB;
constexpr size_t WS_OG = WS_H;
constexpr size_t WS_LS = WS_H + 24 * MiB;
constexpr size_t WS_MG = WS_QA;
constexpr int CW_BAR = 4096;
constexpr int CW_ECNT = 65536;
constexpr int LIST_CAP = 16384;
constexpr int MW_CNT = 16, MW_TB = 48, MW_N2 = 96;
constexpr int RING_BYTES = 131072;
constexpr int LDS_BYTES = 160 * 1024;
constexpr int MISC_OFF = LDS_BYTES - 512;
struct Args { const void* in[25]; float* out; unsigned char* ws; const float* xin; int ph_lo, ph_hi, bar_region, flags; };
static_assert(sizeof(Args) == 25 * 8 + 8 + 8 + 8 + 16, "Args has no padding");
enum { IN_X = 0, IN_C, IN_POS, IN_WADA, IN_BADA, IN_WIN, IN_QNA, IN_KNA, IN_LQ1, IN_LK1, IN_LQ2, IN_LK2, IN_SUBLN, IN_QNB, IN_KNB, IN_WPA, IN_WPB, IN_WO, IN_WR1, IN_BR1, IN_WR2, IN_BR2, IN_WG, IN_WU, IN_WD };

__device__ __forceinline__ int lane_id() { int x; asm volatile("v_mbcnt_lo_u32_b32 %0, -1, 0\n\tv_mbcnt_hi_u32_b32 %0, -1, %0" : "=v"(x)); return x; }
__device__ __forceinline__ float wave_sum(float v) {
#pragma unroll
    for (int o = 1; o < 64; o <<= 1) v += __shfl_xor(v, o);
    return v;
}
__device__ __forceinline__ void transpose_item(const float* W, int K, int N, bf16* WT, int dst_row0, int k0, int n0, LAS float* scr, int lane, int ldk = 0, int kofs = 0) {
    if (ldk == 0) ldk = K; (void)K;
#pragma unroll 8
    for (int i = 0; i < 32; ++i) { const int kk = 2 * i + (lane >> 5); scr[kk * 33 + (lane & 31)] = W[(size_t)(k0 + kk) * N + n0 + (lane & 31)]; }
    LDS_WAIT(); asm volatile("" ::: "memory");
    const int c = lane & 7;
#pragma unroll
    for (int j = 0; j < 4; ++j) { const int n = (lane >> 3) + 8 * j; const LAS float* s = scr + (8 * c) * 33 + n;
        v4u o; o.x = pk2(s[0 * 33], s[1 * 33]); o.y = pk2(s[2 * 33], s[3 * 33]); o.z = pk2(s[4 * 33], s[5 * 33]); o.w = pk2(s[6 * 33], s[7 * 33]);
        *(GAS v4u*)(WT + (size_t)(dst_row0 + n) * ldk + kofs + k0 + 8 * c) = o; }
    LDS_WAIT(); asm volatile("" ::: "memory");
}
__device__ __forceinline__ void convert_layer(const Args& a, int l, LAS unsigned char* lds, int gw, int NGW, int wave, int lane) {
    LAS float* scr = (LAS float*)(lds + wave * 16384);
    unsigned char* ws = a.ws;
    constexpr int I_IN = (D / 64) * (INW / 32), I_PA = (512 / 64) * (D / 32), I_PB = (256 / 64) * (D / 32), I_O = (D / 64) * (D / 32);
    constexpr int I_G = (D / 64) * (DEXP / 32), I_D = (DEXP / 64) * (D / 32);
    constexpr int I_E = 2 * I_G + I_D;
    constexpr int NITEMS = I_IN + I_PA + I_PB + I_O + NEXP * I_E;
    for (int it = gw; it < NITEMS; it += NGW) {
        int r = it;
        if (r < I_IN) { const int nblk = INW / 32, kb = r / nblk, nb = r % nblk, n0 = nb * 32;
            int dst;
            if (n0 < 3840) dst = (n0 & ~255) + 128 * ((n0 >> 5) & 1) + 32 * ((n0 >> 6) & 3);
            else { const int c = (n0 - 3840) & 1023, which = (n0 - 3840) >> 10; dst = (15 + (c >> 7)) * 256 + 128 * which + (c & 127); }
            transpose_item((const float*)a.in[IN_WIN] + (size_t)l * D * INW, D, INW, (bf16*)(ws + WS_WIN), dst, kb * 64, n0, scr, lane); continue; }
        r -= I_IN;
        if (r < I_PA) { const int nblk = D / 32, kb = r / nblk, nb = r % nblk;
            transpose_item((const float*)a.in[IN_WPA] + (size_t)l * 512 * D, 512, D, (bf16*)(ws + WS_WPAB), nb * 32, kb * 64, nb * 32, scr, lane, 768, 0); continue; }
        r -= I_PA;
        if (r < I_PB) { const int nblk = D / 32, kb = r / nblk, nb = r % nblk;
            transpose_item((const float*)a.in[IN_WPB] + (size_t)l * 256 * D, 256, D, (bf16*)(ws + WS_WPAB), nb * 32, kb * 64, nb * 32, scr, lane, 768, 512); continue; }
        r -= I_PB;
        if (r < I_O) { const int nblk = D / 32, kb = r / nblk, nb = r % nblk;
            transpose_item((const float*)a.in[IN_WO] + (size_t)l * D * D, D, D, (bf16*)(ws + WS_WO), nb * 32, kb * 64, nb * 32, scr, lane); continue; }
        r -= I_O;
        const int e = r / I_E; r -= e * I_E;
        if (r < 2 * I_G) { const int up = r >= I_G; if (up) r -= I_G; const int nblk = DEXP / 32, kb = r / nblk, nb = r % nblk, n0 = nb * 32;
            const float* W = (const float*)a.in[up ? IN_WU : IN_WG] + ((size_t)l * NEXP + e) * D * DEXP;
            transpose_item(W, D, DEXP, (bf16*)(ws + WS_WGU), e * 512 + 256 * (n0 >> 7) + (n0 & 127) + (up ? 128 : 0), kb * 64, n0, scr, lane); continue; }
        r -= 2 * I_G;
        { const int nblk = D / 32, kb = r / nblk, nb = r % nblk;
          transpose_item((const float*)a.in[IN_WD] + ((size_t)l * NEXP + e) * DEXP * D, DEXP, D, (bf16*)(ws + WS_WDN), e * 1024 + nb * 32, kb * 64, nb * 32, scr, lane); }
    }
}
__device__ __forceinline__ void prologue_small(const Args& a, LAS unsigned char* lds, int vcu, int G, int wave, int lane, int tid) {
    float* mod = (float*)(a.ws + WS_MOD);
    const float* c = (const float*)a.in[IN_C];
    LAS float* red = (LAS float*)(lds + 8 * 16384);
    for (int it = vcu; it < DEPTH * 96; it += G) {
        const int l = it / 96, ng = it % 96;
        const float* w = (const float*)a.in[IN_WADA] + (size_t)l * D * 6 * D + ng * 64 + lane;
        float a0 = 0.f, a1 = 0.f;
#pragma unroll 8
        for (int k = wave * 128; k < wave * 128 + 128; ++k) { const float wv = w[(size_t)k * 6 * D]; const float c0 = c[k], c1 = c[D + k];
            a0 += (c0 / (1.f + __expf(-c0))) * wv; a1 += (c1 / (1.f + __expf(-c1))) * wv; }
        red[(wave * 2 + 0) * 64 + lane] = a0; red[(wave * 2 + 1) * 64 + lane] = a1;
        __syncthreads();
        if (wave < 2) { float s = 0.f;
#pragma unroll
            for (int ww = 0; ww < 8; ++ww) s += red[(ww * 2 + wave) * 64 + lane];
            mod[((size_t)l * NB + wave) * 6 * D + ng * 64 + lane] = s + ((const float*)a.in[IN_BADA])[l * 6 * D + ng * 64 + lane]; }
        __syncthreads();
    }
    if (vcu == 0 && tid < DEPTH) { const int l = tid; float s1 = 0.f, s2 = 0.f;
        const float* q1 = (const float*)a.in[IN_LQ1] + l * 64; const float* k1 = (const float*)a.in[IN_LK1] + l * 64;
        const float* q2 = (const float*)a.in[IN_LQ2] + l * 64; const float* k2 = (const float*)a.in[IN_LK2] + l * 64;
        for (int k = 0; k < 64; ++k) { s1 += q1[k] * k1[k]; s2 += q2[k] * k2[k]; }
        const float li = 0.8f - 0.6f * (float)exp(-0.3 * (double)l);
        mod[DEPTH * NB * 6 * D + 4 * l] = expf(s1) - expf(s2) + li; mod[DEPTH * NB * 6 * D + 4 * l + 1] = li;
        float ga = 0.f, gb = 0.f, gc = 0.f, gd = 0.f;
        for (int k = 0; k < 64; ++k) { ga = fmaxf(ga, fabsf(((const float*)a.in[IN_QNA])[l * 64 + k])); gb = fmaxf(gb, fabsf(((const float*)a.in[IN_KNA])[l * 64 + k]));
                                       gc = fmaxf(gc, fabsf(((const float*)a.in[IN_QNB])[l * 64 + k])); gd = fmaxf(gd, fabsf(((const float*)a.in[IN_KNB])[l * 64 + k])); }
        mod[DEPTH * NB * 6 * D + 4 * l + 2] = -8.0f * 1.4426950408889634f * ga * gb; mod[DEPTH * NB * 6 * D + 4 * l + 3] = -8.0f * 1.4426950408889634f * gc * gd; }
    { float* cs = (float*)(a.ws + WS_CS); const int* pos = (const int*)a.in[IN_POS];
      const int j = tid & 31; const float inv = (float)pow(10000.0, -(double)(2 * j) / 64.0);
      for (int t = vcu * 16 + (tid >> 5); t < T; t += G * 16) { const float ang = (float)pos[t] * inv;
          cs[(size_t)t * 64 + j] = (float)cos((double)ang); cs[(size_t)t * 64 + 32 + j] = (float)sin((double)ang); } }
}
__device__ __forceinline__ void norm_rows(const float* X, const float* modl  , int shift_off, int scale_off, bf16* H, int gw, int NGW, int lane) {
    for (int m = gw; m < T; m += NGW) {
        const GAS f32x4* xr = (const GAS f32x4*)(X + (size_t)m * D) + lane;
        f32x4 v[4]; float ss = 0.f;
#pragma unroll
        for (int j = 0; j < 4; ++j) { v[j] = xr[64 * j]; ss += (v[j].x * v[j].x + v[j].y * v[j].y) + (v[j].z * v[j].z + v[j].w * v[j].w); }
        const float r = 1.0f / sqrtf(wave_sum(ss) * (1.f / D) + EPS);
        const float* mb = modl + (size_t)(m / S) * 6 * D;
        GAS unsigned long long* o8 = (GAS unsigned long long*)(H + (size_t)m * D) + lane;
#pragma unroll
        for (int j = 0; j < 4; ++j) { const f32x4 sc = *((const f32x4*)(mb + scale_off) + lane + 64 * j), sh = *((const f32x4*)(mb + shift_off) + lane + 64 * j);
            const float y0 = v[j].x * r * (1.f + sc.x) + sh.x, y1 = v[j].y * r * (1.f + sc.y) + sh.y, y2 = v[j].z * r * (1.f + sc.z) + sh.z, y3 = v[j].w * r * (1.f + sc.w) + sh.w;
            o8[64 * j] = (unsigned long long)pk2(y0, y1) | ((unsigned long long)pk2(y2, y3) << 32); }
    }
}
struct EpiG1 {
    static constexpr bool PERM = true, AFTER_DRAIN = false; static constexpr int MID_T = -1;
    unsigned char* ws; const float* cs; const float* qna; const float* kna; const float* qnb; const float* knb;
    __device__ __forceinline__ void operator()(const pg8::f32x4 (&acc)[2][2][4][2], const pg8::Unit& u, int wr, int wc, int fr_, int fq_) const {
        (void)fr_; (void)fq_; const int ln_ = lane_id(); const int fr = ln_ & 15, fq = ln_ >> 4;
        const int pn = u.pn;
        int mode, ld, ct; size_t off; const float* gain = nullptr; float qs = 1.f;
        if (pn < 2) { mode = 0; off = WS_QA; ld = 512; ct = pn; gain = qna; qs = C2; }
        else if (pn < 4) { mode = 0; off = WS_KA; ld = 512; ct = pn - 2; gain = kna; }
        else if (pn < 6) { mode = 1; off = WS_VA; ld = 512; ct = pn - 4; }
        else if (pn < 9) { mode = 0; off = WS_QB; ld = 768; ct = pn - 6; gain = qnb; qs = C2; }
        else if (pn < 12) { mode = 0; off = WS_KB; ld = 768; ct = pn - 9; gain = knb; }
        else if (pn < 15) { mode = 1; off = WS_VB; ld = 768; ct = pn - 12; }
        else { mode = 2; off = WS_GA; ld = 1024; ct = pn - 15; }
        bf16* dst = (bf16*)(ws + off) + ct * 256 + 64 * wc + 8 * fq;
        const int row0 = u.pm * 256 + wr * 64 + fr;
        if (mode == 0) {
            float g1[8], g2[8];
#pragma unroll
            for (int j = 0; j < 8; ++j) { g1[j] = gain[8 * fq + j] * qs; g2[j] = gain[32 + 8 * fq + j] * qs; }
#pragma unroll
            for (int ai = 0; ai < 2; ++ai)
#pragma unroll
                for (int m = 0; m < 4; ++m) {
                    const int r = row0 + ai * 128 + m * 16;
                    float x1[8], x2[8]; float ss = 0.f;
#pragma unroll
                    for (int n = 0; n < 2; ++n)
#pragma unroll
                        for (int i = 0; i < 4; ++i) { x1[4 * n + i] = acc[ai][0][m][n][i]; x2[4 * n + i] = acc[ai][1][m][n][i]; ss += x1[4 * n + i] * x1[4 * n + i] + x2[4 * n + i] * x2[4 * n + i]; }
                    ss += __shfl_xor(ss, 16); ss += __shfl_xor(ss, 32);
                    const float rinv = __builtin_amdgcn_rsqf(ss * (1.f / 64) + EPS);
                    const pg8::f32x4 c0 = *(const pg8::f32x4*)(cs + (size_t)r * 64 + 8 * fq), c1 = *(const pg8::f32x4*)(cs + (size_t)r * 64 + 8 * fq + 4);
                    const pg8::f32x4 s0 = *(const pg8::f32x4*)(cs + (size_t)r * 64 + 32 + 8 * fq), s1 = *(const pg8::f32x4*)(cs + (size_t)r * 64 + 32 + 8 * fq + 4);
                    const float co[8] = {c0[0], c0[1], c0[2], c0[3], c1[0], c1[1], c1[2], c1[3]}, si[8] = {s0[0], s0[1], s0[2], s0[3], s1[0], s1[1], s1[2], s1[3]};
                    float o1[8], o2[8];
#pragma unroll
                    for (int j = 0; j < 8; ++j) { const float y1 = x1[j] * rinv * g1[j], y2 = x2[j] * rinv * g2[j]; o1[j] = y1 * co[j] - y2 * si[j]; o2[j] = y2 * co[j] + y1 * si[j]; }
                    pg8::u32x4 w1, w2;
                    w1.x = pg8::cvt_pk_bf16(o1[0], o1[1]); w1.y = pg8::cvt_pk_bf16(o1[2], o1[3]); w1.z = pg8::cvt_pk_bf16(o1[4], o1[5]); w1.w = pg8::cvt_pk_bf16(o1[6], o1[7]);
                    w2.x = pg8::cvt_pk_bf16(o2[0], o2[1]); w2.y = pg8::cvt_pk_bf16(o2[2], o2[3]); w2.z = pg8::cvt_pk_bf16(o2[4], o2[5]); w2.w = pg8::cvt_pk_bf16(o2[6], o2[7]);
                    *(pg8::u32x4*)(dst + (size_t)r * ld) = w1; *(pg8::u32x4*)(dst + (size_t)r * ld + 32) = w2;
                }
        } else if (mode == 1) {
#pragma unroll
            for (int ai = 0; ai < 2; ++ai)
#pragma unroll
                for (int m = 0; m < 4; ++m) {
                    const int r = row0 + ai * 128 + m * 16;
#pragma unroll
                    for (int bj = 0; bj < 2; ++bj) {
                        const pg8::f32x4 v0 = acc[ai][bj][m][0], v1 = acc[ai][bj][m][1];
                        pg8::u32x4 w; w.x = pg8::cvt_pk_bf16(v0[0], v0[1]); w.y = pg8::cvt_pk_bf16(v0[2], v0[3]); w.z = pg8::cvt_pk_bf16(v1[0], v1[1]); w.w = pg8::cvt_pk_bf16(v1[2], v1[3]);
                        *(pg8::u32x4*)(dst + (size_t)r * ld + 32 * bj) = w;
                    }
                }
        } else {
            bf16* dga = (bf16*)(ws + WS_GA) + ct * 128 + 32 * wc + 8 * fq; bf16* dgb = (bf16*)(ws + WS_GB) + ct * 128 + 32 * wc + 8 * fq;
#pragma unroll
            for (int ai = 0; ai < 2; ++ai)
#pragma unroll
                for (int m = 0; m < 4; ++m) {
                    const int r = row0 + ai * 128 + m * 16;
                    float ra[8], sb[8];
#pragma unroll
                    for (int j = 0; j < 8; ++j) { const float ga_ = acc[ai][0][m][j >> 2][j & 3], gb_ = fmaxf(acc[ai][1][m][j >> 2][j & 3], -30.0f);
                        const float eb = 1.0f + __expf(-gb_); sb[j] = __builtin_amdgcn_rcpf(eb); ra[j] = __builtin_amdgcn_rcpf(1.0f + __expf(-ga_)) * eb; }
                    pg8::u32x4 w1, w2;
                    w1.x = pg8::cvt_pk_bf16(ra[0], ra[1]); w1.y = pg8::cvt_pk_bf16(ra[2], ra[3]); w1.z = pg8::cvt_pk_bf16(ra[4], ra[5]); w1.w = pg8::cvt_pk_bf16(ra[6], ra[7]);
                    w2.x = pg8::cvt_pk_bf16(sb[0], sb[1]); w2.y = pg8::cvt_pk_bf16(sb[2], sb[3]); w2.z = pg8::cvt_pk_bf16(sb[4], sb[5]); w2.w = pg8::cvt_pk_bf16(sb[6], sb[7]);
                    *(pg8::u32x4*)(dga + (size_t)r * 1024) = w1; *(pg8::u32x4*)(dgb + (size_t)r * 1024) = w2;
                }
        }
    }
};

__device__ __forceinline__ void unpack8(const pg8::u32x4 w, float (&f)[8]) {
    f[0] = __uint_as_float(w.x << 16); f[1] = __uint_as_float(w.x & 0xffff0000u); f[2] = __uint_as_float(w.y << 16); f[3] = __uint_as_float(w.y & 0xffff0000u);
    f[4] = __uint_as_float(w.z << 16); f[5] = __uint_as_float(w.z & 0xffff0000u); f[6] = __uint_as_float(w.w << 16); f[7] = __uint_as_float(w.w & 0xffff0000u);
}
struct EpiG2 {
    static constexpr bool PERM = true, AFTER_DRAIN = false; static constexpr int MID_T = 8;
    const bf16* ratio; const bf16* sgb; bf16* mg;
    __device__ __forceinline__ void mid(pg8::f32x4 (&acc)[2][2][4][2], const pg8::Unit& u, int wr, int wc) const {
        const int ln_ = lane_id(); const int fr = ln_ & 15, fq = ln_ >> 4;
        const int row0 = u.pm * 256 + wr * 64 + fr, col0 = u.pn * 256 + wc * 32 + 8 * fq;
#pragma unroll
        for (int ai = 0; ai < 2; ++ai)
#pragma unroll
            for (int m = 0; m < 4; ++m) {
                const size_t rb = (size_t)(row0 + ai * 128 + m * 16) * 1024 + col0;
#pragma unroll
                for (int bj = 0; bj < 2; ++bj) { float g[8]; unpack8(*(const pg8::u32x4*)(ratio + rb + bj * 128), g);
#pragma unroll
                    for (int j = 0; j < 8; ++j) acc[ai][bj][m][j >> 2][j & 3] *= g[j]; }
            }
    }
    __device__ __forceinline__ void operator()(const pg8::f32x4 (&acc)[2][2][4][2], const pg8::Unit& u, int wr, int wc, int fr_, int fq_) const {
        (void)fr_; (void)fq_; const int ln_ = lane_id(); const int fr = ln_ & 15, fq = ln_ >> 4;
        const int row0 = u.pm * 256 + wr * 64 + fr, col0 = u.pn * 256 + wc * 32 + 8 * fq;
#pragma unroll
        for (int ai = 0; ai < 2; ++ai)
#pragma unroll
            for (int m = 0; m < 4; ++m) {
                const size_t rb = (size_t)(row0 + ai * 128 + m * 16) * 1024 + col0;
#pragma unroll
                for (int bj = 0; bj < 2; ++bj) {
                    float g[8]; unpack8(*(const pg8::u32x4*)(sgb + rb + bj * 128), g);
                    float o[8];
#pragma unroll
                    for (int j = 0; j < 8; ++j) o[j] = g[j] * acc[ai][bj][m][j >> 2][j & 3];
                    pg8::u32x4 w; w.x = pg8::cvt_pk_bf16(o[0], o[1]); w.y = pg8::cvt_pk_bf16(o[2], o[3]); w.z = pg8::cvt_pk_bf16(o[4], o[5]); w.w = pg8::cvt_pk_bf16(o[6], o[7]);
                    *(pg8::u32x4*)(mg + rb + bj * 128) = w;
                }
                asm volatile("" ::: "memory");
            }
    }
};
struct EpiG3 {
    static constexpr bool PERM = false, AFTER_DRAIN = false; static constexpr int MID_T = -1;
    const float* xin; float* xout; const float* gate;
    __device__ __forceinline__ void operator()(const pg8::f32x4 (&acc)[2][2][4][2], const pg8::Unit& u, int wr, int wc, int fr_, int fq_) const {
        (void)fr_; (void)fq_; const int ln_ = lane_id(); const int fr = ln_ & 15, fq = ln_ >> 4;
        const int row0 = u.pm * 256 + wr * 64 + fr, col0 = u.pn * 256 + wc * 32 + 4 * fq;
        const float* gb = gate + (size_t)((u.pm * 256) / S) * 6 * D + col0;
        pg8::f32x4 gv[2][2];
#pragma unroll
        for (int bj = 0; bj < 2; ++bj)
#pragma unroll
            for (int n = 0; n < 2; ++n) gv[bj][n] = *(const pg8::f32x4*)(gb + bj * 128 + n * 16);
#pragma unroll
        for (int ai = 0; ai < 2; ++ai)
#pragma unroll
            for (int m = 0; m < 4; ++m) {
                const size_t rb = (size_t)(row0 + ai * 128 + m * 16) * D + col0;
#pragma unroll
                for (int bj = 0; bj < 2; ++bj)
#pragma unroll
                    for (int n = 0; n < 2; ++n) { const pg8::f32x4 xv = *(const pg8::f32x4*)(xin + rb + bj * 128 + n * 16);
                        *(pg8::f32x4*)(xout + rb + bj * 128 + n * 16) = xv + gv[bj][n] * acc[ai][bj][m][n]; }
                if (m & 1) asm volatile("" ::: "memory");
            }
    }
};

template <int M> __device__ __forceinline__ float xor_lane(float x) { return __int_as_float(__builtin_amdgcn_ds_swizzle(__float_as_int(x), (M << 10) | 0x1F)); }
#define N2_LEVEL(v, n, M) do { const bool b_ = (lane & (M)) != 0; _Pragma("unroll") for (int i_ = 0; i_ < (n) / 2; ++i_) { const float keep_ = b_ ? v[i_ + (n) / 2] : v[i_], send_ = b_ ? v[i_] : v[i_ + (n) / 2]; v[i_] = keep_ + xor_lane<M>(send_); } } while (0)
constexpr int N2_LD = 1028;
__device__ __forceinline__ void n2_route(float ve  , float vg  , LAS float* scr, int lane, int m, bool live, float* rtw, LAS int* lent, volatile LAS unsigned* lcnt, volatile LAS unsigned* lnum) {
    if (lane < 32) scr[4 + lane] = ve; if (lane < 4) scr[lane] = vg;
    LDS_WAIT();
    const f32x4 g4 = *(const LAS f32x4*)scr;
    const float mm = fmaxf(fmaxf(g4.x, g4.y), fmaxf(g4.z, g4.w));
    const float p0 = expf(g4.x - mm), p1 = expf(g4.y - mm), p2 = expf(g4.z - mm), p3 = expf(g4.w - mm), sum = ((p0 + p1) + p2) + p3;
    int gi = 0; float pbest = p0 / sum;
    { const float q1 = p1 / sum, q2 = p2 / sum, q3 = p3 / sum; if (q1 > pbest) { pbest = q1; gi = 1; } if (q2 > pbest) { pbest = q2; gi = 2; } if (q3 > pbest) { pbest = q3; gi = 3; } }
    const f32x4 ea = *(const LAS f32x4*)(scr + 4 + gi * 8), eb = *(const LAS f32x4*)(scr + 8 + gi * 8);
    const float ig[8] = {ea.x, ea.y, ea.z, ea.w, eb.x, eb.y, eb.z, eb.w};
    int i0 = 0; float b0 = ig[0];
#pragma unroll
    for (int e = 1; e < 8; ++e) if (ig[e] > b0) { b0 = ig[e]; i0 = e; }
    int i1 = -1; float b1 = -INFINITY;
#pragma unroll
    for (int e = 0; e < 8; ++e) if (e != i0 && (i1 < 0 || ig[e] > b1)) { b1 = ig[e]; i1 = e; }
    const float e1 = expf(b1 - b0);
    if (lane == 0 && live) {
        const int ea_ = gi * 8 + i0, eb_ = gi * 8 + i1;
        rtw[(size_t)m * 2] = pbest / (1.f + e1); rtw[(size_t)m * 2 + 1] = pbest * e1 / (1.f + e1);
        const unsigned pa = __hip_atomic_fetch_add((LAS unsigned*)(lcnt + ea_), 1u, __ATOMIC_RELAXED, __HIP_MEMORY_SCOPE_WORKGROUP), pb = __hip_atomic_fetch_add((LAS unsigned*)(lcnt + eb_), 1u, __ATOMIC_RELAXED, __HIP_MEMORY_SCOPE_WORKGROUP);
        const unsigned n = __hip_atomic_fetch_add((LAS unsigned*)lnum, 2u, __ATOMIC_RELAXED, __HIP_MEMORY_SCOPE_WORKGROUP);
        lent[3 * n] = m * 2; lent[3 * n + 1] = ea_; lent[3 * n + 2] = (int)pa;
        lent[3 * n + 3] = m * 2 + 1; lent[3 * n + 4] = eb_; lent[3 * n + 5] = (int)pb;
    }
    LDS_WAIT();
}
__device__ __forceinline__ void n2_rows(const Args& a, int l, const float* X, const float* modl, LAS unsigned char* lds, volatile LAS unsigned* MISC, int vcu, int G, int wave, int lane) {
    LAS float* Wl = (LAS float*)lds;
    const float* wr1 = (const float*)a.in[IN_WR1] + (size_t)l * D * 4; const float* wr2 = (const float*)a.in[IN_WR2] + (size_t)l * D * 32;
    const int tid = wave * 64 + lane;
#pragma unroll 1
    for (int i0 = 0; i0 < 64; i0 += 16) { float t_[16];
#pragma unroll
        for (int i = 0; i < 16; ++i) t_[i] = wr2[tid + NTHR * (i0 + i)];
#pragma unroll
        for (int i = 0; i < 16; ++i) { const int idx = tid + NTHR * (i0 + i); Wl[(4 + (idx & 31)) * N2_LD + (idx >> 5)] = t_[i]; } }
    { float t_[8];
#pragma unroll
      for (int i = 0; i < 8; ++i) t_[i] = wr1[tid + NTHR * i];
#pragma unroll
      for (int i = 0; i < 8; ++i) { const int idx = tid + NTHR * i; Wl[(idx & 3) * N2_LD + (idx >> 2)] = t_[i]; } }
    LAS int* lent = (LAS int*)(lds + 36 * N2_LD * 4);
    LAS float* scr = (LAS float*)(lds + MISC_OFF - 2048) + wave * 64;
    volatile LAS unsigned* lcnt = MISC + MW_CNT;
    volatile LAS unsigned* lnum = MISC + MW_N2;
    if (tid < 32) lcnt[tid] = 0u; if (tid == 32) lnum[0] = 0u;
    __syncthreads();
    const float bias_e = ((const float*)a.in[IN_BR2])[l * 32 + (lane & 31)], bias_g = ((const float*)a.in[IN_BR1])[l * 4 + (lane & 3)];
    bf16* H = (bf16*)(a.ws + WS_H); float* rtw = (float*)(a.ws + WS_RTW);
    const int gw = vcu * NWAVES + wave, NGW = G * NWAVES;
    for (int m0 = gw; m0 < T; m0 += 2 * NGW) {
        const int m1r = m0 + NGW; const bool live1 = m1r < T; const int m1 = live1 ? m1r : m0;
        f32x4 v0[4], v1[4]; float ss0 = 0.f, ss1 = 0.f;
        { const GAS f32x4* x0 = (const GAS f32x4*)(X + (size_t)m0 * D) + lane; const GAS f32x4* x1 = (const GAS f32x4*)(X + (size_t)m1 * D) + lane;
#pragma unroll
          for (int j = 0; j < 4; ++j) { v0[j] = x0[64 * j]; v1[j] = x1[64 * j]; }
#pragma unroll
          for (int j = 0; j < 4; ++j) { ss0 += (v0[j].x * v0[j].x + v0[j].y * v0[j].y) + (v0[j].z * v0[j].z + v0[j].w * v0[j].w); ss1 += (v1[j].x * v1[j].x + v1[j].y * v1[j].y) + (v1[j].z * v1[j].z + v1[j].w * v1[j].w); } }
        const float r0 = 1.0f / sqrtf(wave_sum(ss0) * (1.f / D) + EPS), r1 = 1.0f / sqrtf(wave_sum(ss1) * (1.f / D) + EPS);
        const float* mb0 = modl + (size_t)(m0 / S) * 6 * D; const float* mb1 = modl + (size_t)(m1 / S) * 6 * D;
        GAS unsigned long long* o0 = (GAS unsigned long long*)(H + (size_t)m0 * D) + lane; GAS unsigned long long* o1 = (GAS unsigned long long*)(H + (size_t)m1 * D) + lane;
#pragma unroll
        for (int j = 0; j < 4; ++j) {
            { const f32x4 sc = *((const f32x4*)(mb0 + 4096) + lane + 64 * j), sh = *((const f32x4*)(mb0 + 3072) + lane + 64 * j);
              v0[j].x = v0[j].x * r0 * (1.f + sc.x) + sh.x; v0[j].y = v0[j].y * r0 * (1.f + sc.y) + sh.y; v0[j].z = v0[j].z * r0 * (1.f + sc.z) + sh.z; v0[j].w = v0[j].w * r0 * (1.f + sc.w) + sh.w;
              o0[64 * j] = (unsigned long long)pk2(v0[j].x, v0[j].y) | ((unsigned long long)pk2(v0[j].z, v0[j].w) << 32); }
            { const f32x4 sc = *((const f32x4*)(mb1 + 4096) + lane + 64 * j), sh = *((const f32x4*)(mb1 + 3072) + lane + 64 * j);
              v1[j].x = v1[j].x * r1 * (1.f + sc.x) + sh.x; v1[j].y = v1[j].y * r1 * (1.f + sc.y) + sh.y; v1[j].z = v1[j].z * r1 * (1.f + sc.z) + sh.z; v1[j].w = v1[j].w * r1 * (1.f + sc.w) + sh.w;
              if (live1) o1[64 * j] = (unsigned long long)pk2(v1[j].x, v1[j].y) | ((unsigned long long)pk2(v1[j].z, v1[j].w) << 32); } }
        float pe0[32], pe1[32], pg0[4], pg1[4];
#pragma unroll
        for (int ob = 0; ob < 36; ob += 4) {
            f32x4 w[4][4];
#pragma unroll
            for (int oo = 0; oo < 4; ++oo)
#pragma unroll
                for (int j = 0; j < 4; ++j) w[oo][j] = *((const LAS f32x4*)(Wl + (ob + oo) * N2_LD) + lane + 64 * j);
#pragma unroll
            for (int oo = 0; oo < 4; ++oo) { float a0 = 0.f, a1 = 0.f;
#pragma unroll
                for (int j = 0; j < 4; ++j) { const f32x4 ww = w[oo][j];
                    a0 = fmaf(v0[j].x, ww.x, a0); a0 = fmaf(v0[j].y, ww.y, a0); a0 = fmaf(v0[j].z, ww.z, a0); a0 = fmaf(v0[j].w, ww.w, a0);
                    a1 = fmaf(v1[j].x, ww.x, a1); a1 = fmaf(v1[j].y, ww.y, a1); a1 = fmaf(v1[j].z, ww.z, a1); a1 = fmaf(v1[j].w, ww.w, a1); }
                const int o = ob + oo;
                if (o < 4) { pg0[o] = a0; pg1[o] = a1; } else { pe0[o - 4] = a0; pe1[o - 4] = a1; } }
        }
        N2_LEVEL(pe0, 32, 16); N2_LEVEL(pe1, 32, 16); N2_LEVEL(pe0, 16, 8); N2_LEVEL(pe1, 16, 8); N2_LEVEL(pe0, 8, 4); N2_LEVEL(pe1, 8, 4);
        N2_LEVEL(pe0, 4, 2); N2_LEVEL(pe1, 4, 2); N2_LEVEL(pe0, 2, 1); N2_LEVEL(pe1, 2, 1);
        N2_LEVEL(pg0, 4, 2); N2_LEVEL(pg1, 4, 2); N2_LEVEL(pg0, 2, 1); N2_LEVEL(pg1, 2, 1);
        float e0 = pe0[0], e1 = pe1[0], g0 = pg0[0], g1 = pg1[0];
        g0 += xor_lane<4>(g0); g1 += xor_lane<4>(g1); g0 += xor_lane<8>(g0); g1 += xor_lane<8>(g1); g0 += xor_lane<16>(g0); g1 += xor_lane<16>(g1);
        e0 += __shfl_xor(e0, 32); e1 += __shfl_xor(e1, 32); g0 += __shfl_xor(g0, 32); g1 += __shfl_xor(g1, 32);
        n2_route(e0 + bias_e, g0 + bias_g, scr, lane, m0, true, rtw, lent, lcnt, lnum);
        n2_route(e1 + bias_e, g1 + bias_g, scr, lane, m1, live1, rtw, lent, lcnt, lnum);
    }
    __syncthreads();
    gu32* ecnt = (gu32*)(a.ws + WS_CTL) + CW_ECNT + l * 32 * 16;
    if (tid < 32) { const unsigned c = lcnt[tid]; lcnt[tid] = c ? __hip_atomic_fetch_add(ecnt + tid * 16, c, RLX_AGENT) : 0u; }
    __syncthreads();
    int* list = (int*)(a.ws + WS_LIST);
    const int n = (int)lnum[0];
    for (int i = tid; i < n; i += NTHR) { const int e = lent[3 * i + 1]; list[e * LIST_CAP + (int)lcnt[e] + lent[3 * i + 2]] = lent[3 * i]; }
    __syncthreads();
}
#undef N2_LEVEL
__device__ __forceinline__ void moe_tables(const Args& a, int l, volatile LAS unsigned* MISC, int wave, int lane) {
    __syncthreads();
    if (wave == 0) {
        const gu32* ecnt = (const gu32*)(a.ws + WS_CTL) + CW_ECNT + l * 32 * 16;
        unsigned c = lane < 32 ? __hip_atomic_load(ecnt + lane * 16, RLX_AGENT) : 0u;
        if (c > (unsigned)LIST_CAP) c = LIST_CAP;
        unsigned tl = (c + 255u) >> 8, inc = tl;
#pragma unroll
        for (int o = 1; o < 32; o <<= 1) { const unsigned y = __shfl_up(inc, o); if (lane >= o) inc += y; }
        if (lane < 32) { MISC[MW_CNT + lane] = c; MISC[MW_TB + lane] = inc - tl; }
        if (lane == 31) MISC[MW_TB + 32] = inc;
    }
    __syncthreads();
}
struct MoeSched {
    volatile LAS unsigned* MISC; const int* list; int npn, G, c; bool g4;
    __device__ __forceinline__ bool next(int i, pg8::Unit& u) const {
        const int L = i * G + c; const int nt = (int)MISC[MW_TB + 32];
        if (L >= nt * npn) return false;
        const int ct = L / npn, pnl = L - ct * npn;
        int e = 0;
        for (int k = 16; k >= 1; k >>= 1) if (e + k < 32 && (int)MISC[MW_TB + e + k] <= ct) e += k;
        const int rt = ct - (int)MISC[MW_TB + e];
        if (g4) { u.pm = e * 64 + rt; u.pn = e * 2 + pnl; } else { u.pm = ct; u.pn = e * 4 + pnl; }
        return true;
    }
    __device__ __forceinline__ int a_row(const pg8::Unit& u, int r) const { const int e = u.pm >> 6, ri = (u.pm & 63) * 256 + r; return ri < (int)MISC[MW_CNT + e] ? (list[e * LIST_CAP + ri] >> 1) : 0; }
    __device__ __forceinline__ void a_ready(const pg8::Unit&) const {}
    __device__ __forceinline__ void done(const pg8::Unit&) const {}
};
struct EpiG4 {
    static constexpr bool PERM = true, AFTER_DRAIN = false; static constexpr int MID_T = -1;
    bf16* hid; volatile LAS unsigned* MISC;
    __device__ __forceinline__ void operator()(const pg8::f32x4 (&acc)[2][2][4][2], const pg8::Unit& u, int wr, int wc, int fr_, int fq_) const {
        (void)fr_; (void)fq_; const int ln_ = lane_id(); const int fr = ln_ & 15, fq = ln_ >> 4;
        const int e = u.pm >> 6, ct = (int)MISC[MW_TB + e] + (u.pm & 63), pnl = u.pn & 1;
        bf16* dst = hid + (size_t)(ct * 256 + wr * 64 + fr) * DEXP + pnl * 128 + wc * 32 + 8 * fq;
#pragma unroll
        for (int ai = 0; ai < 2; ++ai)
#pragma unroll
            for (int m = 0; m < 4; ++m) { float o[8];
#pragma unroll
                for (int j = 0; j < 8; ++j) { const float gv = acc[ai][0][m][j >> 2][j & 3], uv = acc[ai][1][m][j >> 2][j & 3]; o[j] = gv * __builtin_amdgcn_rcpf(1.0f + __expf(-gv)) * uv; }
                pg8::u32x4 w; w.x = pg8::cvt_pk_bf16(o[0], o[1]); w.y = pg8::cvt_pk_bf16(o[2], o[3]); w.z = pg8::cvt_pk_bf16(o[4], o[5]); w.w = pg8::cvt_pk_bf16(o[6], o[7]);
                *(pg8::u32x4*)(dst + (size_t)(ai * 128 + m * 16) * DEXP) = w; }
    }
};
struct EpiG5 {
    static constexpr bool PERM = true, AFTER_DRAIN = false; static constexpr int MID_T = -1;
    bf16* Y; const int* list; const float* rtw; volatile LAS unsigned* MISC;
    __device__ __forceinline__ void operator()(const pg8::f32x4 (&acc)[2][2][4][2], const pg8::Unit& u, int wr, int wc, int fr_, int fq_) const {
        (void)fr_; (void)fq_; const int ln_ = lane_id(); const int fr = ln_ & 15, fq = ln_ >> 4;
        const int e = u.pn >> 2, pnl = u.pn & 3, rt = u.pm - (int)MISC[MW_TB + e], cnt = (int)MISC[MW_CNT + e];
        const int col0 = pnl * 256 + wc * 32 + 8 * fq;
#pragma unroll
        for (int ai = 0; ai < 2; ++ai)
#pragma unroll
            for (int m = 0; m < 4; ++m) { const int ri = rt * 256 + ai * 128 + wr * 64 + m * 16 + fr;
                if (ri < cnt) { const int ent = list[e * LIST_CAP + ri]; const float w = rtw[ent];
#pragma unroll
                    for (int bj = 0; bj < 2; ++bj) { const pg8::f32x4 v0 = acc[ai][bj][m][0] * w, v1 = acc[ai][bj][m][1] * w;
                        pg8::u32x4 q; q.x = pg8::cvt_pk_bf16(v0[0], v0[1]); q.y = pg8::cvt_pk_bf16(v0[2], v0[3]); q.z = pg8::cvt_pk_bf16(v1[0], v1[1]); q.w = pg8::cvt_pk_bf16(v1[2], v1[3]);
                        *(pg8::u32x4*)(Y + (size_t)ent * D + col0 + bj * 128) = q; } }
                asm volatile("" ::: "memory"); }
    }
};
__device__ __forceinline__ void combine_rows(const float* X1, const bf16* Y, const float* modl, float* Xo, int gw, int NGW, int lane) {
    for (int m = gw; m < T; m += NGW) {
        const float* gb = modl + (size_t)(m / S) * 6 * D + 5120;
#pragma unroll
        for (int j = 0; j < 2; ++j) { const int c0 = 8 * lane + 512 * j;
            float y0[8], y1[8]; unpack8(*(const pg8::u32x4*)(Y + (size_t)(2 * m) * D + c0), y0); unpack8(*(const pg8::u32x4*)(Y + (size_t)(2 * m + 1) * D + c0), y1);
            const f32x4 xa = *(const f32x4*)(X1 + (size_t)m * D + c0), xb = *(const f32x4*)(X1 + (size_t)m * D + c0 + 4);
            const f32x4 ga = *(const f32x4*)(gb + c0), gbv = *(const f32x4*)(gb + c0 + 4);
            f32x4 oa, ob;
            oa.x = xa.x + ga.x * (y0[0] + y1[0]); oa.y = xa.y + ga.y * (y0[1] + y1[1]); oa.z = xa.z + ga.z * (y0[2] + y1[2]); oa.w = xa.w + ga.w * (y0[3] + y1[3]);
            ob.x = xb.x + gbv.x * (y0[4] + y1[4]); ob.y = xb.y + gbv.y * (y0[5] + y1[5]); ob.z = xb.z + gbv.z * (y0[6] + y1[6]); ob.w = xb.w + gbv.w * (y0[7] + y1[7]);
            *(f32x4*)(Xo + (size_t)m * D + c0) = oa; *(f32x4*)(Xo + (size_t)m * D + c0 + 4) = ob; }
    }
}
}
namespace atA {
using bf16x8 = __attribute__((ext_vector_type(8))) short;
using s16x4 = __attribute__((ext_vector_type(4))) short;
using f32x16 = __attribute__((ext_vector_type(16))) float;
using u32x4 = __attribute__((ext_vector_type(4))) unsigned;
typedef __attribute__((address_space(3))) const char* lds_cptr;
typedef short v4i16_t __attribute__((ext_vector_type(4)));
typedef float f32x2_t __attribute__((ext_vector_type(2))); typedef __bf16 bf16x2_t __attribute__((ext_vector_type(2)));
constexpr int S = 8192, NT = S / 64, QP = 512, OP = 768;
constexpr int SLOT = 16384, LDS_K = 0, LDS_V = 3 * SLOT, LDS_WS = 6 * SLOT, LDS_X = 0;
__device__ __forceinline__ int crow(int r, int hi) { return (r & 3) + 8 * (r >> 2) + 4 * hi; }
__device__ __forceinline__ void glds16(const void* gsrc, unsigned lds_dst) { unsigned keep;
    asm volatile("s_mov_b32 %0, m0\n\ts_mov_b32 m0, %2\n\ts_nop 0\n\tglobal_load_lds_dwordx4 %1, off\n\ts_mov_b32 m0, %0" : "=&s"(keep) : "v"(gsrc), "s"(lds_dst) : "memory"); }
__device__ __forceinline__ unsigned cvtpk_s(float lo, float hi) { f32x2_t v = {lo, hi}; bf16x2_t b = __builtin_convertvector(v, bf16x2_t); return __builtin_bit_cast(unsigned, b); }
__device__ __forceinline__ s16x4 vtr(lds_cptr p) { return __builtin_bit_cast(s16x4, __builtin_amdgcn_ds_read_tr16_b64_v4i16((__attribute__((address_space(3))) v4i16_t*)p)); }
__device__ __forceinline__ bf16x8 kld(lds_cptr p) { return *(const __attribute__((address_space(3))) bf16x8*)p; }
#define ATA_WAIT_BAR(N) asm volatile("s_waitcnt vmcnt(" #N ") lgkmcnt(0)\n\ts_barrier" ::: "memory")
#define ATA_MFMA(a, b, c) __builtin_amdgcn_mfma_f32_32x32x16_bf16(a, b, c, 0, 0, 0)
#define ATA_SBAR() __builtin_amdgcn_sched_barrier(0)
#define ATA_PIN(x) asm volatile("" : "+v"(x))

struct Params { const unsigned short* Q; const unsigned short* K; const unsigned short* V; unsigned short* O; float negM, lam, one_minus_li; const float* subln; };

template <int VAR>
__device__ __forceinline__ void unit(const Params& P, int b, int h, int qb, char* shm, int wid) {
    int lane_; asm volatile("v_mbcnt_lo_u32_b32 %0, -1, 0\n\tv_mbcnt_hi_u32_b32 %0, -1, %0" : "=v"(lane_));
    const int lane = lane_, r32 = lane & 31, hi = lane >> 5, mp = wid >> 2, wq = wid & 3;
    const long rowbase = (long)b * S; const int q0 = qb * 128 + wq * 32;
    const unsigned lds0 = (unsigned)(uintptr_t)shm;
    float* wsf = (float*)(shm + LDS_WS) + wid * 64;
    const int dkey = 8 * wid + (lane >> 3), dsl = lane & 7;
    const unsigned short* ksrc0 = P.K + (rowbase + dkey) * QP + (2 * h + 0) * 64 + ((dsl ^ ((dkey >> 1) & 7)) * 8);
    const unsigned short* ksrc1 = ksrc0 + 64;
    const unsigned short* vsrcA = P.V + (rowbase + dkey) * QP + h * 128 + (((dsl >> 2) ^ ((dkey >> 1) & 1)) * 32) + (dsl & 3) * 8;
    const unsigned short* vsrcB = vsrcA + 64;
    const unsigned kdst = lds0 + LDS_K + wid * 1024, vdst = lds0 + LDS_V + wid * 1024;
#define DMA_K(t, slot) do { if (VAR == 1 || VAR == 3) break; glds16(ksrc0 + (long)(t) * 64 * QP, (unsigned)__builtin_amdgcn_readfirstlane(kdst + (slot))); glds16(ksrc1 + (long)(t) * 64 * QP, (unsigned)__builtin_amdgcn_readfirstlane(kdst + (slot) + 8192)); } while (0)
#define DMA_V(t, slot) do { if (VAR == 1 || VAR == 3) break; glds16(vsrcA + (long)(t) * 64 * QP, (unsigned)__builtin_amdgcn_readfirstlane(vdst + (slot))); glds16(vsrcB + (long)(t) * 64 * QP, (unsigned)__builtin_amdgcn_readfirstlane(vdst + (slot) + 8192)); } while (0)
    const lds_cptr shm3 = (lds_cptr)shm;
    lds_cptr kpd[4];
#pragma unroll
    for (int d0 = 0; d0 < 4; ++d0) kpd[d0] = shm3 + LDS_K + mp * 8192 + r32 * 128 + (((2 * d0 + hi) ^ ((r32 >> 1) & 7)) * 16);
    const int vq = (lane & 15) >> 2, vsq = (vq >> 1) & 1;
    const lds_cptr vpA = shm3 + LDS_V + ((lane >> 4) & 1) * 32 + (lane & 3) * 8 + (4 * hi + vq) * 128 + vsq * 64;
    const lds_cptr vpB = shm3 + LDS_V + ((lane >> 4) & 1) * 32 + (lane & 3) * 8 + (4 * hi + vq) * 128 + (vsq ^ 1) * 64;
    DMA_K(0, 0); DMA_V(0, 0); DMA_K(1, SLOT);
    bf16x8 qr[4];
    { const unsigned short* Qw = P.Q + (rowbase + q0) * QP + (2 * h + mp) * 64;
#pragma unroll
      for (int d0 = 0; d0 < 4; ++d0) qr[d0] = *reinterpret_cast<const bf16x8*>(&Qw[(long)r32 * QP + d0 * 16 + hi * 8]); }
    DMA_K(2, 2 * SLOT);
    f32x16 o[4]; o[0] = f32x16{}; o[1] = f32x16{}; o[2] = f32x16{}; o[3] = f32x16{};
    f32x16 negm;
    { float nm = P.negM; asm volatile("" : "+v"(nm));
#pragma unroll
      for (int r = 0; r < 16; ++r) negm[r] = nm; }
    ATA_PIN(negm);
    float l_reg = 0.f;
    bf16x8 kf[8];
    f32x16 pA0, pA1, pB0, pB1;
    ATA_WAIT_BAR(6);
#pragma unroll
    for (int d0 = 0; d0 < 4; ++d0) { kf[2 * d0] = kld(kpd[d0]); kf[2 * d0 + 1] = kld(kpd[d0] + 4096); }
    pA0 = ATA_MFMA(kf[0], qr[0], negm); pA1 = ATA_MFMA(kf[1], qr[0], negm);
#pragma unroll
    for (int d0 = 1; d0 < 4; ++d0) { pA0 = ATA_MFMA(kf[2 * d0], qr[d0], pA0); pA1 = ATA_MFMA(kf[2 * d0 + 1], qr[d0], pA1); }
#pragma unroll
    for (int r = 0; r < 16; ++r) { pA0[r] = __builtin_amdgcn_exp2f(pA0[r]); pA1[r] = __builtin_amdgcn_exp2f(pA1[r]); }
    ATA_WAIT_BAR(0);
    DMA_K(3, 0); DMA_V(1, SLOT);
#pragma unroll
    for (int d0 = 0; d0 < 4; ++d0) { kf[2 * d0] = kld(kpd[d0] + SLOT); kf[2 * d0 + 1] = kld(kpd[d0] + SLOT + 4096); }
    ATA_WAIT_BAR(4);
    int sl_prev = 0, sl_cur = SLOT, sl_next = 2 * SLOT;
#define ROT() do { sl_prev = sl_cur; sl_cur = sl_next; sl_next = (sl_next == 2 * SLOT) ? 0 : sl_next + SLOT; } while (0)
    s16x4 vlo[8], vhi[8]; u32x4 pw0, pw1, pw2, pw3;
    if (VAR == 4) {
#pragma unroll
        for (int i = 0; i < 8; ++i) { vlo[i] = s16x4{1, 2, 3, 4}; vhi[i] = s16x4{5, 6, 7, 8}; ATA_PIN(vlo[i]); ATA_PIN(vhi[i]); } }
#define PKW(Pt, B) cvtpk_s(Pt[B], Pt[B + 1])
#define PAF(k) __builtin_bit_cast(bf16x8, pw##k)
#define VFR(i) (bf16x8){vlo[i][0], vlo[i][1], vlo[i][2], vlo[i][3], vhi[i][0], vhi[i][1], vhi[i][2], vhi[i][3]}
#define VOFF(i) ((((i) >> 3) * 8192) + (((i) & 3) * 2048))
#define VRD(i, s) do { if (VAR == 4) break; vlo[s] = vtr(((((i) >> 2) & 1) ? vpB_ : vpA_) + VOFF(i)); vhi[s] = vtr(((((i) >> 2) & 1) ? vpB_ : vpA_) + VOFF(i) + 1024); } while (0)
#define EX(v) (VAR == 2 ? (v) * 0.5f : __builtin_amdgcn_exp2f(v))
#define GAPA(MF, A0, A1, A2, A3, W0, W1, PW) do { MF; sacc += A0; sacc += A1; sacc += A2; sacc += A3; ATA_PIN(sacc); W0; W1; ATA_PIN(PW); ATA_SBAR(); } while (0)
#define GAPB(MF, X, B) do { MF; X[B] = EX(X[B]); X[B + 1] = EX(X[B + 1]); ATA_PIN(X); ATA_SBAR(); } while (0)
#define KRD(G, j) do { if (G) { kf[j] = kld(kpd[(j) >> 1] + sl_next + ((j) & 1) * 4096); ATA_SBAR(); } } while (0)
#define STEP(C0, C1, P0, P1, t, GK, GV, GL) do { ATA_SBAR(); \
    const lds_cptr vpA_ = vpA + sl_prev, vpB_ = vpB + sl_prev; \
    VRD(0, 0); ATA_SBAR(); float sacc = (P0[0] + P0[1]); \
    GAPA(C0 = ATA_MFMA(kf[0], qr[0], negm), P0[2], P0[3], P0[4], P0[5],     pw0[0] = PKW(P0, 0), pw0[1] = PKW(P0, 2), pw0); \
    VRD(1, 1); ATA_SBAR(); GAPA(C1 = ATA_MFMA(kf[1], qr[0], negm), P0[6], P0[7], P0[8], P0[9],     pw0[2] = PKW(P0, 4), pw0[3] = PKW(P0, 6), pw0); \
    VRD(2, 2); ATA_SBAR(); GAPA(C0 = ATA_MFMA(kf[2], qr[1], C0),   P0[10], P0[11], P0[12], P0[13], pw1[0] = PKW(P0, 8), pw1[1] = PKW(P0, 10), pw1); \
    VRD(3, 3); ATA_SBAR(); GAPA(C1 = ATA_MFMA(kf[3], qr[1], C1),   P0[14], P0[15], P1[0], P1[1],   pw1[2] = PKW(P0, 12), pw1[3] = PKW(P0, 14), pw1); \
    VRD(4, 4); ATA_SBAR(); GAPA(C0 = ATA_MFMA(kf[4], qr[2], C0),   P1[2], P1[3], P1[4], P1[5],     pw2[0] = PKW(P1, 0), pw2[1] = PKW(P1, 2), pw2); \
    VRD(5, 5); ATA_SBAR(); GAPA(C1 = ATA_MFMA(kf[5], qr[2], C1),   P1[6], P1[7], P1[8], P1[9],     pw2[2] = PKW(P1, 4), pw2[3] = PKW(P1, 6), pw2); \
    VRD(6, 6); ATA_SBAR(); GAPA(C0 = ATA_MFMA(kf[6], qr[3], C0),   P1[10], P1[11], P1[12], P1[13], pw3[0] = PKW(P1, 8), pw3[1] = PKW(P1, 10), pw3); \
    VRD(7, 7); ATA_SBAR(); GAPA(C1 = ATA_MFMA(kf[7], qr[3], C1),   P1[14], P1[15], 0.f, 0.f,       pw3[2] = PKW(P1, 12), pw3[3] = PKW(P1, 14), pw3); \
    l_reg += sacc; \
    if (mp == 0) { if (GK) { DMA_K((t) + 3, sl_cur); } if (GV) { DMA_V((t) + 1, sl_next); } }     \
    ATA_SBAR(); \
    GAPB(o[0] = ATA_MFMA(PAF(0), VFR(0), o[0]), C0, 0);  VRD(8, 0);  ATA_SBAR(); \
    GAPB(o[0] = ATA_MFMA(PAF(1), VFR(1), o[0]), C0, 2);  VRD(9, 1);  ATA_SBAR(); \
    GAPB(o[0] = ATA_MFMA(PAF(2), VFR(2), o[0]), C0, 4);  VRD(10, 2); ATA_SBAR(); \
    GAPB(o[0] = ATA_MFMA(PAF(3), VFR(3), o[0]), C0, 6);  VRD(11, 3); ATA_SBAR(); \
    GAPB(o[1] = ATA_MFMA(PAF(0), VFR(4), o[1]), C0, 8);  VRD(12, 4); ATA_SBAR(); \
    GAPB(o[1] = ATA_MFMA(PAF(1), VFR(5), o[1]), C0, 10); VRD(13, 5); ATA_SBAR(); \
    GAPB(o[1] = ATA_MFMA(PAF(2), VFR(6), o[1]), C0, 12); VRD(14, 6); ATA_SBAR(); \
    GAPB(o[1] = ATA_MFMA(PAF(3), VFR(7), o[1]), C0, 14); VRD(15, 7); ATA_SBAR(); \
    if (mp == 1) { if (GK) { DMA_K((t) + 3, sl_cur); } if (GV) { DMA_V((t) + 1, sl_next); } } \
    ATA_SBAR(); \
    KRD(GL, 0); GAPB(o[2] = ATA_MFMA(PAF(0), VFR(0), o[2]), C1, 0); \
    KRD(GL, 1); GAPB(o[2] = ATA_MFMA(PAF(1), VFR(1), o[2]), C1, 2); \
    KRD(GL, 2); GAPB(o[2] = ATA_MFMA(PAF(2), VFR(2), o[2]), C1, 4); \
    KRD(GL, 3); GAPB(o[2] = ATA_MFMA(PAF(3), VFR(3), o[2]), C1, 6); \
    KRD(GL, 4); GAPB(o[3] = ATA_MFMA(PAF(0), VFR(4), o[3]), C1, 8); \
    KRD(GL, 5); GAPB(o[3] = ATA_MFMA(PAF(1), VFR(5), o[3]), C1, 10); \
    KRD(GL, 6); GAPB(o[3] = ATA_MFMA(PAF(2), VFR(6), o[3]), C1, 12); \
    KRD(GL, 7); GAPB(o[3] = ATA_MFMA(PAF(3), VFR(7), o[3]), C1, 14); \
    } while (0)
    int t = 1;
#pragma unroll 1
    for (; t < NT - 3; t += 2) {
        STEP(pB0, pB1, pA0, pA1, t, true, true, true);     if (VAR == 3) { asm volatile("s_waitcnt lgkmcnt(0)" ::: "memory"); } else { ATA_WAIT_BAR(4); } ROT();
        STEP(pA0, pA1, pB0, pB1, t + 1, true, true, true); if (VAR == 3) { asm volatile("s_waitcnt lgkmcnt(0)" ::: "memory"); } else { ATA_WAIT_BAR(4); } ROT();
    }
    STEP(pB0, pB1, pA0, pA1, NT - 3, false, true, true);  ATA_WAIT_BAR(2); ROT();
    STEP(pA0, pA1, pB0, pB1, NT - 2, false, true, true);  ATA_WAIT_BAR(2); ROT();
    STEP(pB0, pB1, pA0, pA1, NT - 1, false, false, false); ATA_WAIT_BAR(0); ROT();
    { float sacc = 0.f;
#pragma unroll
      for (int r = 0; r < 16; ++r) sacc += pB0[r] + pB1[r];
      l_reg += sacc;
      pw0 = (u32x4){PKW(pB0, 0), PKW(pB0, 2), PKW(pB0, 4), PKW(pB0, 6)}; pw1 = (u32x4){PKW(pB0, 8), PKW(pB0, 10), PKW(pB0, 12), PKW(pB0, 14)};
      pw2 = (u32x4){PKW(pB1, 0), PKW(pB1, 2), PKW(pB1, 4), PKW(pB1, 6)}; pw3 = (u32x4){PKW(pB1, 8), PKW(pB1, 10), PKW(pB1, 12), PKW(pB1, 14)};
      const lds_cptr vpA_ = vpA + sl_prev, vpB_ = vpB + sl_prev;
#pragma unroll
      for (int d0 = 0; d0 < 4; ++d0) { const lds_cptr vb = ((d0 & 1) ? vpB_ : vpA_) + (d0 >> 1) * 8192;
          const s16x4 a0 = vtr(vb), b0 = vtr(vb + 1024), a1 = vtr(vb + 2048), b1 = vtr(vb + 3072);
          const s16x4 a2 = vtr(vb + 4096), b2 = vtr(vb + 5120), a3 = vtr(vb + 6144), b3 = vtr(vb + 7168);
#define VF2(a, b) (bf16x8){a[0], a[1], a[2], a[3], b[0], b[1], b[2], b[3]}
          o[d0] = ATA_MFMA(PAF(0), VF2(a0, b0), o[d0]); o[d0] = ATA_MFMA(PAF(1), VF2(a1, b1), o[d0]); o[d0] = ATA_MFMA(PAF(2), VF2(a2, b2), o[d0]); o[d0] = ATA_MFMA(PAF(3), VF2(a3, b3), o[d0]);
#undef VF2
      } }
    l_reg += __shfl_xor(l_reg, 32);
    if (hi == 0) wsf[r32] = l_reg;
    asm volatile("s_waitcnt lgkmcnt(0)\n\ts_barrier" ::: "memory");
    float rli[16];
#pragma unroll
    for (int r = 0; r < 16; ++r) rli[r] = 1.0f / wsf[crow(r, hi)];
    float* X = (float*)(shm + LDS_X) + wq * 4096;
    if (mp == 1) {
#pragma unroll
        for (int d0 = 0; d0 < 4; ++d0)
#pragma unroll
            for (int r = 0; r < 16; ++r) X[crow(r, hi) * 128 + d0 * 32 + r32] = o[d0][r] * rli[r];
    }
    asm volatile("s_waitcnt lgkmcnt(0)\n\ts_barrier" ::: "memory");
    if (mp == 0) {
        float ss[16];
#pragma unroll
        for (int r = 0; r < 16; ++r) ss[r] = 0.f;
#pragma unroll
        for (int d0 = 0; d0 < 4; ++d0)
#pragma unroll
            for (int r = 0; r < 16; ++r) { const float av = o[d0][r] * rli[r] - P.lam * X[crow(r, hi) * 128 + d0 * 32 + r32]; o[d0][r] = av; ss[r] += av * av; }
#pragma unroll
        for (int r = 0; r < 16; ++r) {
            float v = ss[r];
#pragma unroll
            for (int of = 1; of < 32; of <<= 1) v += __shfl_xor(v, of);
            ss[r] = P.one_minus_li / sqrtf(v * (1.0f / 128) + 1e-6f);
        }
        unsigned short* Ow = P.O + (rowbase + q0) * OP + h * 128;
#pragma unroll
        for (int d0 = 0; d0 < 4; ++d0) { const float gsub = P.subln[d0 * 32 + r32];
#pragma unroll
            for (int r = 0; r < 16; ++r) { const float y = o[d0][r] * ss[r] * gsub; unsigned u = __float_as_uint(y); u = (u + 0x7fffu + ((u >> 16) & 1u)) >> 16;
                Ow[(long)crow(r, hi) * OP + d0 * 32 + r32] = (unsigned short)u; } }
    }
    asm volatile("s_waitcnt lgkmcnt(0)\n\ts_barrier" ::: "memory");
#undef DMA_K
#undef DMA_V
#undef ROT
#undef PKW
#undef PAF
#undef VFR
#undef VOFF
#undef VRD
#undef EX
#undef GAPA
#undef GAPB
#undef KRD
#undef STEP
}
}
namespace atB {
using bf16x8 = __attribute__((ext_vector_type(8))) short;
using s16x4 = __attribute__((ext_vector_type(4))) short;
using f32x16 = __attribute__((ext_vector_type(16))) float;
using u32x4 = __attribute__((ext_vector_type(4))) unsigned;
typedef __attribute__((address_space(3))) const char* lds_cptr;
typedef short v4i16_t __attribute__((ext_vector_type(4)));
constexpr int S = 8192, QP = 768;
__device__ __forceinline__ int crow(int r, int hi) { return (r & 3) + 8 * (r >> 2) + 4 * hi; }
__device__ __forceinline__ s16x4 vtr(lds_cptr p) { return __builtin_bit_cast(s16x4, __builtin_amdgcn_ds_read_tr16_b64_v4i16((__attribute__((address_space(3))) v4i16_t*)p)); }
__device__ __forceinline__ unsigned cvtpk(float lo, float hi) { typedef float f2 __attribute__((ext_vector_type(2))); typedef __bf16 b2 __attribute__((ext_vector_type(2))); f2 v = {lo, hi}; b2 b = __builtin_convertvector(v, b2); return __builtin_bit_cast(unsigned, b); }
struct Params { const unsigned short* Q; const unsigned short* K; const unsigned short* V; unsigned short* OG  ; float* LS  ; float negM; };

__device__ __forceinline__ void wave_tile(const Params& P, int g, int b, int hh, int tile256, char* vst, int lane) {
    const int dil = g == 0 ? 1 : (g == 1 ? 4 : 16), L = S / dil, tpr = 256 / dil;
    const int res = tile256 / tpr, t0 = 32 * (tile256 % tpr);
    const int r32 = lane & 31, hi = lane >> 5, hc = (g * 4 + hh) * 64;
    const size_t seq0 = (size_t)b * S + res;
    bf16x8 qr[4];
    { const unsigned short* qp = P.Q + (seq0 + (size_t)(t0 + r32) * dil) * QP + hc + hi * 8;
#pragma unroll
      for (int d0 = 0; d0 < 4; ++d0) qr[d0] = *reinterpret_cast<const bf16x8*>(qp + d0 * 16); }
    f32x16 o[2]; o[0] = f32x16{}; o[1] = f32x16{};
    float l_reg = 0.f;
    const lds_cptr vp0 = (lds_cptr)vst + ((lane >> 4) & 1) * 32 + (lane & 3) * 8 + (4 * hi + ((lane & 15) >> 2)) * 64;
    bf16x8 kf[5][4];
#pragma unroll
    for (int j = 0; j < 5; ++j) { int tkc = t0 - 64 + 32 * j + r32; tkc = tkc < 0 ? 0 : (tkc > L - 1 ? L - 1 : tkc);
        const unsigned short* kp = P.K + (seq0 + (size_t)tkc * dil) * QP + hc + hi * 8;
#pragma unroll
        for (int d0 = 0; d0 < 4; ++d0) kf[j][d0] = *reinterpret_cast<const bf16x8*>(kp + d0 * 16); }
    u32x4 vv[4], vn[4];
#define WIN_VLOAD(dst, j) do { _Pragma("unroll") for (int i = 0; i < 4; ++i) { const int idx_ = 64 * i + lane, key_ = idx_ >> 3, ch_ = idx_ & 7; int tv_ = t0 - 64 + 32 * (j) + key_; tv_ = tv_ < 0 ? 0 : (tv_ > L - 1 ? L - 1 : tv_); \
        dst[i] = *reinterpret_cast<const u32x4*>(P.V + (seq0 + (size_t)tv_ * dil) * QP + hc + ch_ * 8); } } while (0)
    WIN_VLOAD(vv, 0);
#pragma unroll
    for (int j = 0; j < 5; ++j) {
        const int tk0 = t0 - 64 + 32 * j;
        if (j < 4) WIN_VLOAD(vn, j + 1);
        f32x16 c = __builtin_amdgcn_mfma_f32_32x32x16_bf16(kf[j][0], qr[0], f32x16{}, 0, 0, 0);
#pragma unroll
        for (int d0 = 1; d0 < 4; ++d0) c = __builtin_amdgcn_mfma_f32_32x32x16_bf16(kf[j][d0], qr[d0], c, 0, 0, 0);
        float sacc = 0.f;
#pragma unroll
        for (int r = 0; r < 16; ++r) { const int kk = crow(r, hi), tk = tk0 + kk, df = tk - (t0 + r32);
            const bool ok = (df >= -64) && (df <= 64) && (tk >= 0) && (tk < L);
            const float p = ok ? __builtin_amdgcn_exp2f(c[r] + P.negM) : 0.f; c[r] = p; sacc += p; }
        l_reg += sacc;
        const u32x4 pw0 = (u32x4){cvtpk(c[0], c[1]), cvtpk(c[2], c[3]), cvtpk(c[4], c[5]), cvtpk(c[6], c[7])};
        const u32x4 pw1 = (u32x4){cvtpk(c[8], c[9]), cvtpk(c[10], c[11]), cvtpk(c[12], c[13]), cvtpk(c[14], c[15])};
        asm volatile("s_waitcnt lgkmcnt(0)" ::: "memory");
#pragma unroll
        for (int i = 0; i < 4; ++i) { const int idx = 64 * i + lane, key = idx >> 3, ch = idx & 7;
            *reinterpret_cast<__attribute__((address_space(3))) u32x4*>((__attribute__((address_space(3))) char*)vst + (ch >> 2) * 2048 + key * 64 + (ch & 3) * 16) = vv[i]; }
        asm volatile("s_waitcnt lgkmcnt(0)" ::: "memory");
#pragma unroll
        for (int db = 0; db < 2; ++db)
#pragma unroll
            for (int ks = 0; ks < 2; ++ks) { const s16x4 lo_ = vtr(vp0 + db * 2048 + ks * 1024), hi_ = vtr(vp0 + db * 2048 + ks * 1024 + 512);
                const bf16x8 vf = (bf16x8){lo_[0], lo_[1], lo_[2], lo_[3], hi_[0], hi_[1], hi_[2], hi_[3]};
                o[db] = __builtin_amdgcn_mfma_f32_32x32x16_bf16(__builtin_bit_cast(bf16x8, ks == 0 ? pw0 : pw1), vf, o[db], 0, 0, 0); }
        if (j < 4) {
#pragma unroll
            for (int i = 0; i < 4; ++i) vv[i] = vn[i]; }
    }
#undef WIN_VLOAD
    l_reg += __shfl_xor(l_reg, 32);
    if (hi == 0) P.LS[(seq0 + (size_t)(t0 + r32) * dil) * 12 + g * 4 + hh] = l_reg;
#pragma unroll
    for (int db = 0; db < 2; ++db)
#pragma unroll
        for (int r = 0; r < 16; ++r) { unsigned u = __float_as_uint(o[db][r]); u = (u + 0x7fffu + ((u >> 16) & 1u)) >> 16;
            P.OG[((seq0 + (size_t)(t0 + crow(r, hi)) * dil) * 3 + g) * 256 + hh * 64 + db * 32 + r32] = (unsigned short)u; }
    asm volatile("s_waitcnt lgkmcnt(0)" ::: "memory");
}
}
namespace mk {
constexpr int PH_PRO = 0, PH_L0 = 1, PH_PER_LAYER = 10, PH_FINAL = PH_L0 + DEPTH * PH_PER_LAYER, PH_COUNT = PH_FINAL + 1;
enum { P_N1 = 0, P_G1, P_AT, P_CB, P_G2, P_G3, P_N2, P_G4, P_G5, P_PAD };
constexpr int FLAG_NO_COMBINE = 1;

__global__ void __launch_bounds__(NTHR, 2) mk_fwd(Args a) {
    extern __shared__ __attribute__((aligned(16))) unsigned char lds_raw[];
    LAS unsigned char* lds = (LAS unsigned char*)lds_raw;
    volatile LAS unsigned* MISC = (volatile LAS unsigned*)(lds + MISC_OFF);
    const int wave = __builtin_amdgcn_readfirstlane((int)threadIdx.x >> 6);

    const int G = gridDim.x, bx = blockIdx.x; const int vcu = (G % 8 == 0) ? (bx % 8) * (G / 8) + bx / 8 : bx;
    const int gw = vcu * NWAVES + wave, NGW = G * NWAVES;
    gu32* ctl = (gu32*)(a.ws + WS_CTL);
    { const int t0 = wave * 64 + lane_id(); if (t0 < 128) MISC[t0] = 0u; }
    __syncthreads();
    XcdBarrier bar = xcd_barrier_post((unsigned*)(ctl + CW_BAR) + a.bar_region * XCD_BAR_WORDS, MISC + 8);
    const int lo = a.ph_lo, hi = a.ph_hi;
#define IN(k) (lo <= (k) && (k) < hi)
#define SEAM(k) do { if (IN(k) && IN((k) + 1)) xcd_barrier(bar); } while (0)
    const float* mod = (const float*)(a.ws + WS_MOD);

    if (IN(PH_PRO)) { const int lane = lane_id(); prologue_small(a, lds, vcu, G, wave, lane, wave * 64 + lane); convert_layer(a, 0, lds, gw, NGW, wave, lane); }
    SEAM(PH_PRO);
#pragma unroll 1
    for (int l = 0; l < DEPTH; ++l) {
        const int pb = PH_L0 + l * PH_PER_LAYER;
        const float* modl = mod + (size_t)l * NB * 6 * D;
        if (IN(pb + P_N1)) {
            int lane_p = lane_id(), wave_p = wave; asm volatile("" : "+v"(lane_p), "+s"(wave_p));
            const int gw_p = vcu * NWAVES + wave_p;
            if (l > 0) { convert_layer(a, l, lds, gw_p, NGW, wave_p, lane_p);
                if (!(a.flags & FLAG_NO_COMBINE)) combine_rows(a.out, (const bf16*)(a.ws + WS_Y), modl - (size_t)NB * 6 * D, a.out, gw_p, NGW, lane_p); }
            norm_rows((l == 0 && !(a.flags & FLAG_NO_COMBINE)) ? a.xin : a.out, modl, 0, 1024, (bf16*)(a.ws + WS_H), gw_p, NGW, lane_p);
        }
        SEAM(pb + P_N1);
        if (IN(pb + P_G1)) {
            pg8::Gemm g{(const pg8::bf16_t*)(a.ws + WS_H), (const pg8::bf16_t*)(a.ws + WS_WIN), T, INW, D};
            pg8::StaticOrder So; So.init(T, INW, G, bx);
            EpiG1 E{a.ws, (const float*)(a.ws + WS_CS), (const float*)a.in[IN_QNA] + l * 64, (const float*)a.in[IN_KNA] + l * 64, (const float*)a.in[IN_QNB] + l * 64, (const float*)a.in[IN_KNB] + l * 64};
            pg8::gemm_phase<EpiG1, pg8::StaticOrder, true, true>(lds, g, So, E, wave);
        }
        SEAM(pb + P_G1);
        if (IN(pb + P_AT)) {
            const float* lw = mod + DEPTH * NB * 6 * D + 4 * l;
            { atB::Params PB{(const unsigned short*)(a.ws + WS_QB), (const unsigned short*)(a.ws + WS_KB), (const unsigned short*)(a.ws + WS_VB), (unsigned short*)(a.ws + WS_OG), (float*)(a.ws + WS_LS), lw[3]};
              const int lane_p = lane_id();
              for (int w = vcu * NWAVES + wave; w < 6144; w += NGW) { const int g = w >> 11, rem = w & 2047; atB::wave_tile(PB, g, rem >> 10, (rem >> 8) & 3, rem & 255, (char*)lds_raw + wave * 4096, lane_p); }
              __syncthreads(); }
            atA::Params P{(const unsigned short*)(a.ws + WS_QA), (const unsigned short*)(a.ws + WS_KA), (const unsigned short*)(a.ws + WS_VA), (unsigned short*)(a.ws + WS_OUTAB),
                          lw[2], lw[0], 1.0f - lw[1], (const float*)a.in[IN_SUBLN] + l * 128};
            for (int u = vcu; u < 512; u += G) { const int bh = (u >> 5) & 7, qb = (u & 31) + 32 * (u >> 8); atA::unit<0>(P, bh >> 2, bh & 3, qb, (char*)lds_raw, wave); }
        }
        SEAM(pb + P_AT);
        if (IN(pb + P_G2)) {
            pg8::StaticOrder So; So.init(T, D, G, bx);
            { const unsigned short* OG = (const unsigned short*)(a.ws + WS_OG); const float* LS = (const float*)(a.ws + WS_LS); bf16* OB = (bf16*)(a.ws + WS_OUTAB) + 512;
              const int tid_p = wave * 64 + lane_id(); pg8::Unit u;
              for (int i = 0; So.next(i, u); ++i)
                  for (int it = tid_p; it < 256 * 32; it += NTHR) { const int t = u.pm * 256 + (it >> 5), c0 = (it & 31) * 8, hh = c0 >> 6;
                      float acc8[8] = {0.f, 0.f, 0.f, 0.f, 0.f, 0.f, 0.f, 0.f}; float ls = 0.f;
#pragma unroll
                      for (int g = 0; g < 3; ++g) { float f[8]; unpack8(*(const pg8::u32x4*)(OG + ((size_t)t * 3 + g) * 256 + c0), f); ls += LS[(size_t)t * 12 + g * 4 + hh];
#pragma unroll
                          for (int j = 0; j < 8; ++j) acc8[j] += f[j]; }
                      const float il = __builtin_amdgcn_rcpf(ls);
                      pg8::u32x4 w; w.x = pg8::cvt_pk_bf16(acc8[0] * il, acc8[1] * il); w.y = pg8::cvt_pk_bf16(acc8[2] * il, acc8[3] * il); w.z = pg8::cvt_pk_bf16(acc8[4] * il, acc8[5] * il); w.w = pg8::cvt_pk_bf16(acc8[6] * il, acc8[7] * il);
                      *(pg8::u32x4*)(OB + (size_t)t * 768 + c0) = w; }
              asm volatile("s_waitcnt vmcnt(0)" ::: "memory"); __syncthreads(); }
            pg8::Gemm g{(const pg8::bf16_t*)(a.ws + WS_OUTAB), (const pg8::bf16_t*)(a.ws + WS_WPAB), T, D, 768};
            EpiG2 E{(const bf16*)(a.ws + WS_GA), (const bf16*)(a.ws + WS_GB), (bf16*)(a.ws + WS_MG)};
            pg8::gemm_phase<EpiG2, pg8::StaticOrder, false, true>(lds, g, So, E, wave);
        }
        SEAM(pb + P_G2);
        if (IN(pb + P_G3)) {
            pg8::Gemm g{(const pg8::bf16_t*)(a.ws + WS_MG), (const pg8::bf16_t*)(a.ws + WS_WO), T, D, D};
            pg8::StaticOrder So; So.init(T, D, G, bx);
            EpiG3 E{(l == 0 && !(a.flags & FLAG_NO_COMBINE)) ? a.xin : a.out, a.out, modl + 2048};
            pg8::gemm_phase<EpiG3, pg8::StaticOrder, false, true>(lds, g, So, E, wave);
        }
        SEAM(pb + P_G3);
        if (IN(pb + P_N2)) { int lane_p = lane_id(), wave_p = wave; asm volatile("" : "+v"(lane_p), "+s"(wave_p));
            n2_rows(a, l, a.out, modl, lds, MISC, vcu, G, wave_p, lane_p); }
        SEAM(pb + P_N2);
        if (IN(pb + P_G4)) {
            moe_tables(a, l, MISC, wave, lane_id());
            pg8::Gemm g{(const pg8::bf16_t*)(a.ws + WS_H), (const pg8::bf16_t*)(a.ws + WS_WGU), T, NEXP * 512, D};
            MoeSched So{MISC, (const int*)(a.ws + WS_LIST), 2, G, bx, true};
            EpiG4 E{(bf16*)(a.ws + WS_HID), MISC};
            pg8::gemm_phase_g<EpiG4, MoeSched, false>(lds, g, So, E, wave);
        }
        SEAM(pb + P_G4);
        if (IN(pb + P_G5)) {
            moe_tables(a, l, MISC, wave, lane_id());
            pg8::Gemm g{(const pg8::bf16_t*)(a.ws + WS_HID), (const pg8::bf16_t*)(a.ws + WS_WDN), 40960, NEXP * D, DEXP};
            MoeSched So{MISC, (const int*)(a.ws + WS_LIST), 4, G, bx, false};
            EpiG5 E{(bf16*)(a.ws + WS_Y), (const int*)(a.ws + WS_LIST), (const float*)(a.ws + WS_RTW), MISC};
            pg8::gemm_phase<EpiG5, MoeSched, false, true>(lds, g, So, E, wave);
        }
        SEAM(pb + P_G5);
    }
#ifdef PROBE_VAR
    if (IN(41)) {
        const float* lw = mod + DEPTH * NB * 6 * D + 4;
        atB::Params PB{(const unsigned short*)(a.ws + WS_QB), (const unsigned short*)(a.ws + WS_KB), (const unsigned short*)(a.ws + WS_VB), (unsigned short*)(a.ws + WS_OG), (float*)(a.ws + WS_LS), lw[3]};
        const int lane_p = lane_id();
        for (int w = vcu * NWAVES + wave; w < 6144; w += NGW) { const int g = w >> 11, rem = w & 2047; atB::wave_tile(PB, g, rem >> 10, (rem >> 8) & 3, rem & 255, (char*)lds_raw + wave * 4096, lane_p); }
    }
    if (IN(40)) {
        const float* lw = mod + DEPTH * NB * 6 * D + 4;
        atA::Params P{(const unsigned short*)(a.ws + WS_QA), (const unsigned short*)(a.ws + WS_KA), (const unsigned short*)(a.ws + WS_VA), (unsigned short*)(a.ws + WS_OUTAB),
                      lw[2], lw[0], 1.0f - lw[1], (const float*)a.in[IN_SUBLN] + 128};
        for (int u = vcu; u < 512; u += G) { const int bh = (u >> 5) & 7, qb = (u & 31) + 32 * (u >> 8); atA::unit<PROBE_VAR>(P, bh >> 2, bh & 3, qb, (char*)lds_raw, wave); }
    }
#endif
    if (IN(PH_FINAL)) { int lane_p = lane_id(), wave_p = wave; asm volatile("" : "+v"(lane_p), "+s"(wave_p));
        combine_rows(a.out, (const bf16*)(a.ws + WS_Y), mod + (size_t)(DEPTH - 1) * NB * 6 * D, a.out, vcu * NWAVES + wave_p, NGW, lane_p); }
#undef IN
#undef SEAM
}
}
extern "C" void kernel_launch(void* const* d_in, const int* in_sizes, int n_in, void* d_out, int out_size, void* d_ws, size_t ws_size, hipStream_t stream) {
    using namespace mk;
    const float* x = (const float*)d_in[0];
    float* X = (float*)d_out;
    unsigned char* ws = (unsigned char*)d_ws;
    static int grid = 0;
    if (grid == 0) {
        int dev = 0, cus = 0;
        if (hipGetDevice(&dev) != hipSuccess || hipDeviceGetAttribute(&cus, hipDeviceAttributeMultiprocessorCount, dev) != hipSuccess) { fprintf(stderr, "device query failed\n"); grid = -1; return; }
        if (hipFuncSetAttribute((const void*)mk::mk_fwd, hipFuncAttributeMaxDynamicSharedMemorySize, mk::LDS_BYTES) != hipSuccess) { fprintf(stderr, "hipFuncSetAttribute failed\n"); grid = -1; return; }
        int per_cu = 0;
        if (hipOccupancyMaxActiveBlocksPerMultiprocessor(&per_cu, (const void*)mk::mk_fwd, mk::NTHR, mk::LDS_BYTES) != hipSuccess || per_cu < 1) { fprintf(stderr, "occupancy query says %d\n", per_cu); }
        (void)hipGetLastError();
        if (mk::WS_END > ws_size) { fprintf(stderr, "workspace too small: need %zu have %zu\n", (size_t)mk::WS_END, ws_size); grid = -1; return; }
        grid = cus;
    }
    if (grid < 0) return;

    hipMemsetAsync(ws + mk::WS_CTL, 0, mk::CTL_ZERO_BYTES, stream);
    mk::Args a{};
    for (int i = 0; i < 25; ++i) a.in[i] = d_in[i];
    a.out = X; a.ws = ws; a.xin = x; a.flags = 0;
    int region = 0;
    auto fast = [&](int lo, int hi) { a.ph_lo = lo; a.ph_hi = hi; a.bar_region = region++; hipLaunchKernelGGL(mk::mk_fwd, dim3(grid), dim3(mk::NTHR), mk::LDS_BYTES, stream, a); };

    fast(0, mk::PH_FINAL + 1);
#ifdef PROBE_LO
    fast(PROBE_LO, PROBE_HI);
#endif
}
```

```cpp
#include <hip/hip_runtime.h>
#include <hip/hip_bf16.h>
#include <cstdint>
#include <cstdio>
#include <cmath>
namespace pg8 {
#define PG8_LAS __attribute__((address_space(3)))
typedef unsigned short bf16_t;
typedef short bf16x8 __attribute__((ext_vector_type(8)));
typedef float f32x4 __attribute__((ext_vector_type(4)));
typedef unsigned u32x4 __attribute__((ext_vector_type(4)));
constexpr int BM = 256, BK = 64, HALF = 128, HTB = HALF * BK * 2  , STAGE_BYTES = 8 * HTB, NXCD = 8, WGM = 8;

__host__ __device__ __forceinline__ int lds_byte(int r, int c) { const int st = (r >> 4) * 2 + (c >> 5), rr = r & 15, cc = c & 31, ob = rr * 64 + cc * 2; return st * 1024 + (ob ^ (((ob >> 9) & 1) << 5)); }
__host__ __device__ __forceinline__ void stage_rc(int b, int& R, int& C) { const int st = b / 1024, sb = b % 1024, swz = sb ^ (((sb >> 9) & 1) << 5); R = (st >> 1) * 16 + swz / 64; C = (st & 1) * 32 + (swz % 64) / 2; }
__host__ __device__ __forceinline__ int perm32(int rho) { const int n = rho >> 4, i = rho & 15; return 8 * (i >> 2) + 4 * n + (i & 3); }

struct Unit { int pm, pn; };
struct Gemm { const bf16_t* A; const bf16_t* Bt; int M, N, K; };

struct StaticOrder {
    int nM, nN, nwg, G, c;
    __host__ __device__ void init(int M, int N, int G_, int c_) { nM = M / BM; nN = N / BM; nwg = nM * nN; G = G_; c = c_; }
    __host__ __device__ bool next(int i, Unit& u) const {
        const long L = (long)i * G + c; if (L >= nwg) return false;
        int wgid = (int)L; { const int q = nwg / NXCD, r = nwg % NXCD, xcd = wgid % NXCD, off = wgid / NXCD; wgid = (xcd < r ? xcd * (q + 1) : r * (q + 1) + (xcd - r) * q) + off; }
        const int nig = WGM * nN, gid = wgid / nig, fm = gid * WGM, gsz = (nM - fm) < WGM ? (nM - fm) : WGM;
        u.pm = fm + ((wgid % nig) % gsz); u.pn = (wgid % nig) / gsz; return true;
    }
    __device__ __forceinline__ void a_ready(const Unit&) const {}
    __device__ __forceinline__ void done(const Unit&) const {}
};

__device__ __forceinline__ unsigned cvt_pk_bf16(float lo, float hi) { unsigned r; asm volatile("v_cvt_pk_bf16_f32 %0, %1, %2" : "=v"(r) : "v"(lo), "v"(hi)); return r; }
typedef float f32x2 __attribute__((ext_vector_type(2)));
template <class Epi, class Sched, bool ALIGN_EPI = false, bool SP2 = false>
__device__ __forceinline__ void gemm_phase(PG8_LAS unsigned char* lds, const Gemm g, const Sched& S, const Epi& E, const int wid_arg) {
    int lane_; asm volatile("v_mbcnt_lo_u32_b32 %0, -1, 0\n\tv_mbcnt_hi_u32_b32 %0, -1, %0" : "=v"(lane_));
    const int wid = wid_arg, lane = lane_, tid = wid * 64 + lane, wr = wid >> 2, wc = wid & 3, fr = lane & 15, fq = lane >> 4;
    const int K = g.K, nt = K / BK;
    unsigned voffA[2], voffB[2];
#pragma unroll
    for (int i = 0; i < 2; ++i) { int R, C; stage_rc(tid * 16 + i * 8192, R, C); const int Rb = Epi::PERM ? ((R & ~31) + perm32(R & 31)) : R;
        voffA[i] = (unsigned)(R * K + C) * 2u; voffB[i] = (unsigned)(Rb * K + C) * 2u; }
    const size_t kstep = (size_t)(BK * 2);
    const size_t hstep = (size_t)HALF * K * 2;
    const size_t tstep = 2 * hstep;
    const unsigned ldsw = (unsigned)wid * 1024u;
    const int aoff = lds_byte(wr * 64 + fr, fq * 8), boff = lds_byte(wc * 32 + fr, fq * 8);
#define PG8_SA(b, h) (((b) * 2 + (h)) * HTB)
#define PG8_SB(b, h) ((4 + (b) * 2 + (h)) * HTB)
#define PG8_STAGE(bufoff, gbase, voff) do { _Pragma("unroll") for (int _i = 0; _i < 2; ++_i) \
        __builtin_amdgcn_global_load_lds((const unsigned*)((const char*)(gbase) + (voff)[_i]), (PG8_LAS unsigned*)(lds + (bufoff) + ldsw + _i * 8192), 16, 0, 0); } while (0)
#define PG8_LDA(dst, b, h) do { _Pragma("unroll") for (int m = 0; m < 4; ++m) _Pragma("unroll") for (int k = 0; k < 2; ++k) dst[m][k] = *(const PG8_LAS bf16x8*)(lds + PG8_SA(b, h) + aoff + m * 2048 + k * 1024); } while (0)
#define PG8_LDB(dst, b, h) do { _Pragma("unroll") for (int n = 0; n < 2; ++n) _Pragma("unroll") for (int k = 0; k < 2; ++k) dst[n][k] = *(const PG8_LAS bf16x8*)(lds + PG8_SB(b, h) + boff + n * 2048 + k * 1024); } while (0)
#define PG8_MMA(ai, bj, At, Bt) do { __builtin_amdgcn_s_setprio(1); _Pragma("unroll") for (int m = 0; m < 4; ++m) _Pragma("unroll") for (int n = 0; n < 2; ++n) _Pragma("unroll") for (int k = 0; k < 2; ++k) \
        acc[ai][bj][m][n] = __builtin_amdgcn_mfma_f32_16x16x32_bf16(Bt[n][k], At[m][k], acc[ai][bj][m][n], 0, 0, 0); __builtin_amdgcn_s_setprio(0); } while (0)
#define PG8_WAIT_V(n) asm volatile("s_waitcnt vmcnt(" #n ")" ::: "memory")
#define PG8_WAIT_L(n) asm volatile("s_waitcnt lgkmcnt(" #n ")" ::: "memory")
#define PG8_BAR __builtin_amdgcn_s_barrier()
#define PG8_SCHED __builtin_amdgcn_sched_barrier(0)
    Unit cur, nxt; int ui = 0;
    if (!S.next(0, cur)) return;
    f32x4 acc[2][2][4][2];
#pragma unroll
    for (int a = 0; a < 2; ++a)
#pragma unroll
        for (int b = 0; b < 2; ++b)
#pragma unroll
            for (int m = 0; m < 4; ++m)
#pragma unroll
                for (int n = 0; n < 2; ++n) acc[a][b][m][n] = (f32x4){0.f, 0.f, 0.f, 0.f};
    bf16x8 At[4][2], B0[2][2], B1[2][2];
    const char* cA = (const char*)g.A + (size_t)cur.pm * tstep; const char* cB = (const char*)g.Bt + (size_t)cur.pn * tstep;
    S.a_ready(cur);
    if constexpr (SP2) {
        PG8_STAGE(PG8_SB(0, 0), cB, voffB); PG8_STAGE(PG8_SB(0, 1), cB + hstep, voffB); PG8_STAGE(PG8_SA(0, 0), cA, voffA); PG8_STAGE(PG8_SA(0, 1), cA + hstep, voffA);
        if (wr == 1) PG8_BAR;
        PG8_WAIT_V(2); PG8_BAR;
        PG8_STAGE(PG8_SB(1, 0), cB + kstep, voffB); PG8_STAGE(PG8_SA(1, 0), cA + kstep, voffA); PG8_STAGE(PG8_SB(1, 1), cB + hstep + kstep, voffB);
        PG8_WAIT_V(6); PG8_BAR;
    } else {
        PG8_STAGE(PG8_SB(0, 0), cB, voffB); PG8_STAGE(PG8_SA(0, 0), cA, voffA); PG8_STAGE(PG8_SB(0, 1), cB + hstep, voffB); PG8_STAGE(PG8_SA(0, 1), cA + hstep, voffA);
        if (wr == 1) PG8_BAR;
        PG8_WAIT_V(4); PG8_BAR;
        PG8_STAGE(PG8_SB(1, 0), cB + kstep, voffB); PG8_STAGE(PG8_SA(1, 0), cA + kstep, voffA); PG8_STAGE(PG8_SB(1, 1), cB + hstep + kstep, voffB);
        PG8_WAIT_V(6); PG8_BAR;
    }
    for (;;) {
        const bool has_next = S.next(ui + 1, nxt);
        const char* nA = has_next ? (const char*)g.A + (size_t)nxt.pm * tstep : cA; const char* nB = has_next ? (const char*)g.Bt + (size_t)nxt.pn * tstep : cB;
        for (int t = 0; t < nt; t += 2) {
            const bool last = (t == nt - 2);
            const char* a1 = cA + (size_t)(t + 1) * kstep;
            const char* a2 = last ? nA : cA + (size_t)(t + 2) * kstep; const char* b2 = last ? nB : cB + (size_t)(t + 2) * kstep;
            const char* a3 = a2 + kstep; const char* b3 = b2 + kstep;
            if (last && has_next) S.a_ready(nxt);
            if constexpr (Epi::MID_T >= 0) { if (t == Epi::MID_T) E.mid(acc, cur, wr, wc); }
            if constexpr (SP2) {
            PG8_LDB(B0, 0, 0); PG8_LDB(B1, 0, 1); PG8_SCHED; PG8_LDA(At, 0, 0); PG8_STAGE(PG8_SA(1, 1), a1 + hstep, voffA);
            PG8_WAIT_V(8); PG8_WAIT_L(0); PG8_BAR; PG8_MMA(0, 0, At, B0); PG8_MMA(0, 1, At, B1); PG8_BAR; PG8_SCHED;
            PG8_LDA(At, 0, 1); PG8_STAGE(PG8_SB(0, 0), b2, voffB); PG8_STAGE(PG8_SB(0, 1), b2 + hstep, voffB); PG8_STAGE(PG8_SA(0, 0), a2, voffA);
            PG8_WAIT_V(8); PG8_WAIT_L(0); PG8_BAR; PG8_MMA(1, 0, At, B0); PG8_MMA(1, 1, At, B1); PG8_BAR; PG8_SCHED;
            PG8_LDB(B0, 1, 0); PG8_LDB(B1, 1, 1); PG8_SCHED; PG8_LDA(At, 1, 0); PG8_STAGE(PG8_SA(0, 1), a2 + hstep, voffA);
            PG8_WAIT_V(8); PG8_WAIT_L(0); PG8_BAR; PG8_MMA(0, 0, At, B0); PG8_MMA(0, 1, At, B1); PG8_BAR; PG8_SCHED;
            PG8_LDA(At, 1, 1); PG8_STAGE(PG8_SB(1, 0), b3, voffB); PG8_STAGE(PG8_SB(1, 1), b3 + hstep, voffB); PG8_STAGE(PG8_SA(1, 0), a3, voffA);
            PG8_WAIT_V(8); PG8_WAIT_L(0); PG8_BAR; PG8_MMA(1, 0, At, B0); PG8_MMA(1, 1, At, B1); PG8_BAR; PG8_SCHED;
            } else {
            PG8_LDB(B0, 0, 0); PG8_SCHED; PG8_LDA(At, 0, 0); PG8_STAGE(PG8_SA(1, 1), a1 + hstep, voffA);
            PG8_WAIT_L(8); PG8_BAR; PG8_WAIT_L(0); PG8_MMA(0, 0, At, B0); PG8_BAR; PG8_SCHED;
            PG8_LDB(B1, 0, 1); PG8_STAGE(PG8_SB(0, 0), b2, voffB);
            PG8_BAR; PG8_WAIT_L(0); PG8_MMA(0, 1, At, B1); PG8_BAR;
            PG8_LDA(At, 0, 1); PG8_STAGE(PG8_SA(0, 0), a2, voffA);
            PG8_BAR; PG8_WAIT_L(0); PG8_MMA(1, 0, At, B0); PG8_BAR; PG8_SCHED;
            PG8_STAGE(PG8_SB(0, 1), b2 + hstep, voffB);
            PG8_WAIT_V(6); PG8_BAR; PG8_MMA(1, 1, At, B1); PG8_BAR;
            PG8_LDB(B0, 1, 0); PG8_SCHED; PG8_LDA(At, 1, 0); PG8_STAGE(PG8_SA(0, 1), a2 + hstep, voffA);
            PG8_WAIT_L(8); PG8_BAR; PG8_WAIT_L(0); PG8_MMA(0, 0, At, B0); PG8_BAR; PG8_SCHED;
            PG8_LDB(B1, 1, 1); PG8_STAGE(PG8_SB(1, 0), b3, voffB);
            PG8_BAR; PG8_WAIT_L(0); PG8_MMA(0, 1, At, B1); PG8_BAR;
            PG8_LDA(At, 1, 1); PG8_STAGE(PG8_SA(1, 0), a3, voffA);
            PG8_BAR; PG8_WAIT_L(0); PG8_MMA(1, 0, At, B0); PG8_BAR; PG8_SCHED;
            PG8_STAGE(PG8_SB(1, 1), b3 + hstep, voffB);
            PG8_WAIT_V(6); PG8_BAR; PG8_MMA(1, 1, At, B1); PG8_BAR;
            }
        }
        if constexpr (ALIGN_EPI) { if (wr == 0) PG8_BAR; }
        if constexpr (!Epi::AFTER_DRAIN) { E(acc, cur, wr, wc, fr, fq); S.done(cur); }
        if (!has_next) break;
#pragma unroll
        for (int a = 0; a < 2; ++a)
#pragma unroll
            for (int b = 0; b < 2; ++b)
#pragma unroll
                for (int m = 0; m < 4; ++m)
#pragma unroll
                    for (int n = 0; n < 2; ++n) acc[a][b][m][n] = (f32x4){0.f, 0.f, 0.f, 0.f};
        cur = nxt; cA = nA; cB = nB; ++ui;
        if constexpr (ALIGN_EPI) { if (wr == 1) PG8_BAR; }
    }
    PG8_WAIT_V(0);
    if constexpr (!ALIGN_EPI) { if (wr == 0) PG8_BAR; }
    PG8_BAR;
    if constexpr (Epi::AFTER_DRAIN) { E.fused(acc, cur, wr, wc, fr, fq, lds, wid, lane); S.done(cur); }
#undef PG8_SA
#undef PG8_SB
#undef PG8_STAGE
#undef PG8_LDA
#undef PG8_LDB
#undef PG8_MMA
#undef PG8_WAIT_V
#undef PG8_WAIT_L
#undef PG8_BAR
#undef PG8_SCHED
}
template <class Epi, class Sched, bool ALIGN_EPI = false>
__device__ __forceinline__ void gemm_phase_g(PG8_LAS unsigned char* lds, const Gemm g, const Sched& S, const Epi& E, const int wid_arg) {
    int lane_; asm volatile("v_mbcnt_lo_u32_b32 %0, -1, 0\n\tv_mbcnt_hi_u32_b32 %0, -1, %0" : "=v"(lane_));
    const int wid = wid_arg, lane = lane_, tid = wid * 64 + lane, wr = wid >> 2, wc = wid & 3, fr = lane & 15, fq = lane >> 4;
    const int K = g.K, nt = K / BK;
    unsigned voffB[2]; int ra0, ra1; unsigned ca0, ca1;
#pragma unroll
    for (int i = 0; i < 2; ++i) { int R, C; stage_rc(tid * 16 + i * 8192, R, C); const int Rb = Epi::PERM ? ((R & ~31) + perm32(R & 31)) : R;
        if (i == 0) { ra0 = R; ca0 = (unsigned)C * 2u; } else { ra1 = R; ca1 = (unsigned)C * 2u; } voffB[i] = (unsigned)(Rb * K + C) * 2u; }
    const size_t kstep = (size_t)(BK * 2);
    const size_t hstep = (size_t)HALF * K * 2;
    const size_t tstep = 2 * hstep;
    const unsigned ldsw = (unsigned)wid * 1024u;
    const int aoff = lds_byte(wr * 64 + fr, fq * 8), boff = lds_byte(wc * 32 + fr, fq * 8);
#define PG8_SA(b, h) (((b) * 2 + (h)) * HTB)
#define PG8_SB(b, h) ((4 + (b) * 2 + (h)) * HTB)
#define PG8_STAGE(bufoff, gbase, voff) do { _Pragma("unroll") for (int _i = 0; _i < 2; ++_i) \
        __builtin_amdgcn_global_load_lds((const unsigned*)((const char*)(gbase) + (voff)[_i]), (PG8_LAS unsigned*)(lds + (bufoff) + ldsw + _i * 8192), 16, 0, 0); } while (0)
#define PG8_STAGE_G(bufoff, o0, o1, kb) do { __builtin_amdgcn_global_load_lds((const unsigned*)((const char*)g.A + (o0) + (kb)), (PG8_LAS unsigned*)(lds + (bufoff) + ldsw), 16, 0, 0); \
        __builtin_amdgcn_global_load_lds((const unsigned*)((const char*)g.A + (o1) + (kb)), (PG8_LAS unsigned*)(lds + (bufoff) + ldsw + 8192), 16, 0, 0); } while (0)
#define PG8_GOFS(U, o00, o01, o10, o11) do { o00 = (unsigned)S.a_row(U, ra0) * (unsigned)(K * 2) + ca0; o01 = (unsigned)S.a_row(U, ra1) * (unsigned)(K * 2) + ca1; \
        o10 = (unsigned)S.a_row(U, 128 + ra0) * (unsigned)(K * 2) + ca0; o11 = (unsigned)S.a_row(U, 128 + ra1) * (unsigned)(K * 2) + ca1; } while (0)
#define PG8_LDA(dst, b, h) do { _Pragma("unroll") for (int m = 0; m < 4; ++m) _Pragma("unroll") for (int k = 0; k < 2; ++k) dst[m][k] = *(const PG8_LAS bf16x8*)(lds + PG8_SA(b, h) + aoff + m * 2048 + k * 1024); } while (0)
#define PG8_LDB(dst, b, h) do { _Pragma("unroll") for (int n = 0; n < 2; ++n) _Pragma("unroll") for (int k = 0; k < 2; ++k) dst[n][k] = *(const PG8_LAS bf16x8*)(lds + PG8_SB(b, h) + boff + n * 2048 + k * 1024); } while (0)
#define PG8_MMA(ai, bj, At, Bt) do { __builtin_amdgcn_s_setprio(1); _Pragma("unroll") for (int m = 0; m < 4; ++m) _Pragma("unroll") for (int n = 0; n < 2; ++n) _Pragma("unroll") for (int k = 0; k < 2; ++k) \
        acc[ai][bj][m][n] = __builtin_amdgcn_mfma_f32_16x16x32_bf16(Bt[n][k], At[m][k], acc[ai][bj][m][n], 0, 0, 0); __builtin_amdgcn_s_setprio(0); } while (0)
#define PG8_WAIT_V(n) asm volatile("s_waitcnt vmcnt(" #n ")" ::: "memory")
#define PG8_WAIT_L(n) asm volatile("s_waitcnt lgkmcnt(" #n ")" ::: "memory")
#define PG8_BAR __builtin_amdgcn_s_barrier()
#define PG8_SCHED __builtin_amdgcn_sched_barrier(0)
    Unit cur, nxt; int ui = 0;
    if (!S.next(0, cur)) return;
    f32x4 acc[2][2][4][2];
#pragma unroll
    for (int a = 0; a < 2; ++a)
#pragma unroll
        for (int b = 0; b < 2; ++b)
#pragma unroll
            for (int m = 0; m < 4; ++m)
#pragma unroll
                for (int n = 0; n < 2; ++n) acc[a][b][m][n] = (f32x4){0.f, 0.f, 0.f, 0.f};
    bf16x8 At[4][2], B0[2][2], B1[2][2];
    const char* cB = (const char*)g.Bt + (size_t)cur.pn * tstep;
    unsigned gc00, gc01, gc10, gc11;
    PG8_GOFS(cur, gc00, gc01, gc10, gc11);
    S.a_ready(cur);
    {
        PG8_STAGE(PG8_SB(0, 0), cB, voffB); PG8_STAGE(PG8_SB(0, 1), cB + hstep, voffB); PG8_STAGE_G(PG8_SA(0, 0), gc00, gc01, 0); PG8_STAGE_G(PG8_SA(0, 1), gc10, gc11, 0);
        if (wr == 1) PG8_BAR;
        PG8_WAIT_V(2); PG8_BAR;
        PG8_STAGE(PG8_SB(1, 0), cB + kstep, voffB); PG8_STAGE_G(PG8_SA(1, 0), gc00, gc01, kstep); PG8_STAGE(PG8_SB(1, 1), cB + hstep + kstep, voffB);
        PG8_WAIT_V(6); PG8_BAR;
    }
    for (;;) {
        const bool has_next = S.next(ui + 1, nxt);
        const char* nB = has_next ? (const char*)g.Bt + (size_t)nxt.pn * tstep : cB;
        unsigned gn00 = gc00, gn01 = gc01, gn10 = gc10, gn11 = gc11;
        if (has_next) { PG8_GOFS(nxt, gn00, gn01, gn10, gn11); }
        for (int t = 0; t < nt; t += 2) {
            const bool last = (t == nt - 2);
            const char* b2 = last ? nB : cB + (size_t)(t + 2) * kstep;
            const size_t k2 = last ? (size_t)0 : (size_t)(t + 2) * kstep;
            const unsigned s00 = last ? gn00 : gc00, s01 = last ? gn01 : gc01, s10 = last ? gn10 : gc10, s11 = last ? gn11 : gc11;
            const char* b3 = b2 + kstep;
            if (last && has_next) S.a_ready(nxt);
            {
            PG8_LDB(B0, 0, 0); PG8_LDB(B1, 0, 1); PG8_SCHED; PG8_LDA(At, 0, 0); PG8_STAGE_G(PG8_SA(1, 1), gc10, gc11, (size_t)(t + 1) * kstep);
            PG8_WAIT_V(8); PG8_WAIT_L(0); PG8_BAR; PG8_MMA(0, 0, At, B0); PG8_MMA(0, 1, At, B1); PG8_BAR; PG8_SCHED;
            PG8_LDA(At, 0, 1); PG8_STAGE(PG8_SB(0, 0), b2, voffB); PG8_STAGE(PG8_SB(0, 1), b2 + hstep, voffB); PG8_STAGE_G(PG8_SA(0, 0), s00, s01, k2);
            PG8_WAIT_V(8); PG8_WAIT_L(0); PG8_BAR; PG8_MMA(1, 0, At, B0); PG8_MMA(1, 1, At, B1); PG8_BAR; PG8_SCHED;
            PG8_LDB(B0, 1, 0); PG8_LDB(B1, 1, 1); PG8_SCHED; PG8_LDA(At, 1, 0); PG8_STAGE_G(PG8_SA(0, 1), s10, s11, k2);
            PG8_WAIT_V(8); PG8_WAIT_L(0); PG8_BAR; PG8_MMA(0, 0, At, B0); PG8_MMA(0, 1, At, B1); PG8_BAR; PG8_SCHED;
            PG8_LDA(At, 1, 1); PG8_STAGE(PG8_SB(1, 0), b3, voffB); PG8_STAGE(PG8_SB(1, 1), b3 + hstep, voffB); PG8_STAGE_G(PG8_SA(1, 0), s00, s01, k2 + kstep);
            PG8_WAIT_V(8); PG8_WAIT_L(0); PG8_BAR; PG8_MMA(1, 0, At, B0); PG8_MMA(1, 1, At, B1); PG8_BAR; PG8_SCHED;
            }
        }
        if constexpr (ALIGN_EPI) { if (wr == 0) PG8_BAR; }
        if constexpr (!Epi::AFTER_DRAIN) { E(acc, cur, wr, wc, fr, fq); S.done(cur); }
        if (!has_next) break;
#pragma unroll
        for (int a = 0; a < 2; ++a)
#pragma unroll
            for (int b = 0; b < 2; ++b)
#pragma unroll
                for (int m = 0; m < 4; ++m)
#pragma unroll
                    for (int n = 0; n < 2; ++n) acc[a][b][m][n] = (f32x4){0.f, 0.f, 0.f, 0.f};
        cur = nxt; cB = nB; ++ui; gc00 = gn00; gc01 = gn01; gc10 = gn10; gc11 = gn11;
        if constexpr (ALIGN_EPI) { if (wr == 1) PG8_BAR; }
    }
    PG8_WAIT_V(0);
    if constexpr (!ALIGN_EPI) { if (wr == 0) PG8_BAR; }
    PG8_BAR;
    if constexpr (Epi::AFTER_DRAIN) { E.fused(acc, cur, wr, wc, fr, fq, lds, wid, lane); S.done(cur); }
#undef PG8_SA
#undef PG8_SB
#undef PG8_STAGE
#undef PG8_STAGE_G
#undef PG8_GOFS
#undef PG8_LDA
#undef PG8_LDB
#undef PG8_MMA
#undef PG8_WAIT_V
#undef PG8_WAIT_L
#undef PG8_BAR
#undef PG8_SCHED
}
}
namespace mk {
#define GAS __attribute__((address_space(1)))
#define LAS __attribute__((address_space(3)))
typedef unsigned short bf16;
typedef unsigned v4u __attribute__((ext_vector_type(4)));
typedef float f32x4 __attribute__((ext_vector_type(4)));
typedef short bf16x8 __attribute__((ext_vector_type(8)));
typedef GAS unsigned gu32;
typedef GAS unsigned long long gu64;
#define RLX_AGENT __ATOMIC_RELAXED, __HIP_MEMORY_SCOPE_AGENT
#define LDS_WAIT() asm volatile("s_waitcnt lgkmcnt(0)" ::: "memory")
#define VM_WAIT() asm volatile("s_waitcnt vmcnt(0)" ::: "memory")
__device__ __forceinline__ unsigned long long rt() { return __builtin_amdgcn_s_memrealtime(); }
__device__ __forceinline__ unsigned f2bf(float f) { unsigned u = __builtin_bit_cast(unsigned, f); return (u + 0x7fffu + ((u >> 16) & 1u)) >> 16; }
__device__ __forceinline__ unsigned pk2(float lo, float hi) { return f2bf(lo) | (f2bf(hi) << 16); }
#define XB_TMO      128
#define XB_XCNT(j)  (256  + 64 * (j))
#define XB_XSUB(j)  (1280 + 64 * (j))
#define XB_XGEN(j)  (2304 + 64 * (j))
#define XB_TOP      3328
#define XB_TOPGEN   3392
#define XCD_BAR_WORDS 3456
#define XB_SPIN_CAP (1u << 18)

__device__ __forceinline__ unsigned xb_ld(unsigned* p)              { return __hip_atomic_load(p, __ATOMIC_RELAXED, __HIP_MEMORY_SCOPE_AGENT); }
__device__ __forceinline__ unsigned xb_add(unsigned* p, unsigned v) { return __hip_atomic_fetch_add(p, v, __ATOMIC_RELAXED, __HIP_MEMORY_SCOPE_AGENT); }
__device__ __forceinline__ unsigned xb_xcc_id() { return (unsigned)__builtin_amdgcn_s_getreg((3 << 11) | 20) & 0xFu; }
#define XB_SPIN(cond, bar) do { unsigned _sp = 0; while (cond) { __builtin_amdgcn_s_sleep(1); \
    if ((++_sp & 255u) == 0u) { if (xb_ld(&(bar)[XB_TMO])) break; if (_sp > XB_SPIN_CAP) { atomicAdd(&(bar)[XB_TMO], 1u); break; } } } } while (0)

struct XcdBarrier {
    unsigned* bar; unsigned x;
    volatile LAS unsigned* st;
};

__device__ __forceinline__ XcdBarrier xcd_barrier_post(unsigned* bar, volatile LAS unsigned* st) {
    XcdBarrier b; b.bar = bar; b.x = xb_xcc_id(); b.st = st;
    if (threadIdx.x == 0) (void)xb_add(&bar[XB_XCNT(b.x)], 1u);
    return b;
}
__device__ __forceinline__ void xcd_barrier_complete(unsigned* bar, unsigned x, unsigned& nloc, unsigned& nx) {
    const unsigned G = gridDim.x * gridDim.y * gridDim.z;
    unsigned sum, cnt, mine, sp = 0u;
    for (;;) {
        sum = 0u; cnt = 0u; mine = 0u;
#pragma unroll
        for (unsigned j = 0; j < 16; ++j) { const unsigned c = xb_ld(&bar[XB_XCNT(j)]); sum += c; cnt += (c > 0u) ? 1u : 0u; mine = (j == x) ? c : mine; }
        if (sum == G) break;
        __builtin_amdgcn_s_sleep(1);
        if ((++sp & 255u) == 0u) { if (xb_ld(&bar[XB_TMO])) break; if (sp > XB_SPIN_CAP) { atomicAdd(&bar[XB_TMO], 1u); break; } }
    }
    nloc = mine > 0u ? mine : 1u; nx = cnt > 0u ? cnt : 1u;
}

__device__ __forceinline__ void xcd_barrier(const XcdBarrier& b) {
    asm volatile("s_waitcnt vmcnt(0)" ::: "memory");
    __syncthreads();
    if (threadIdx.x == 0) {
        unsigned* bar = b.bar;
        __builtin_amdgcn_s_waitcnt(0);
        unsigned nloc = b.st[0], nx = b.st[1];
        if (nloc == 0u) { xcd_barrier_complete(bar, b.x, nloc, nx); b.st[0] = nloc; b.st[1] = nx; }
        const unsigned old = xb_add(&bar[XB_XSUB(b.x)], 1u);
        const unsigned gen = old / nloc;
        if (old + 1u == (gen + 1u) * nloc) {
            __builtin_amdgcn_fence(__ATOMIC_RELEASE, "agent");
            asm volatile("s_waitcnt vmcnt(0)" ::: "memory");
            const unsigned og = xb_add(&bar[XB_TOP], 1u);
            const unsigned tg = og / nx;
            if (og + 1u == (tg + 1u) * nx) xb_add(&bar[XB_TOPGEN], 1u);
            else XB_SPIN(xb_ld(&bar[XB_TOPGEN]) == tg, bar);
            __builtin_amdgcn_fence(__ATOMIC_ACQUIRE, "agent");
            xb_add(&bar[XB_XGEN(b.x)], 1u);
            asm volatile("s_waitcnt vmcnt(0)" ::: "memory");
        } else {
            XB_SPIN(xb_ld(&bar[XB_XGEN(b.x)]) == gen, bar);
            __builtin_amdgcn_fence(__ATOMIC_ACQUIRE, "agent");
            asm volatile("s_waitcnt vmcnt(0)" ::: "memory");
        }
    }
    __syncthreads();
}
}
namespace mk {
constexpr int NWAVES = 8, NTHR = 512;
constexpr int D = 1024, NB = 2, S = 8192, T = NB * S, DEPTH = 2, INW = 5888, NEXP = 32, DEXP = 256;
constexpr float EPS = 1e-6f;
constexpr float C2 = 0.125f * 1.4426950408889634f;
constexpr size_t MiB = 1u << 20;
constexpr size_t WS_CTL = 0, CTL_ZERO_BYTES = 1 * MiB;
constexpr size_t WS_MOD = 1 * MiB;
constexpr size_t WS_CS = 2 * MiB;
constexpr size_t WS_WIN = 6 * MiB;
constexpr size_t WS_WPAB = 18 * MiB;
constexpr size_t WS_WO = 20 * MiB;
constexpr size_t WS_WGU = 22 * MiB;
constexpr size_t WS_WDN = 54 * MiB;
constexpr size_t WS_H = 70 * MiB;
constexpr size_t WS_QA = 102 * MiB, WS_KA = 118 * MiB, WS_VA = 134 * MiB;
constexpr size_t WS_QB = 150 * MiB, WS_KB = 174 * MiB, WS_VB = 198 * MiB;
constexpr size_t WS_GA = 222 * MiB, WS_GB = 254 * MiB;
constexpr size_t WS_OUTAB = 286 * MiB;
constexpr size_t WS_LIST = 310 * MiB;
constexpr size_t WS_RTW = 312 * MiB;
constexpr size_t WS_END = 313 * MiB;
constexpr size_t WS_HID = WS_VA;
constexpr size_t WS_Y = WS_KB;
constexpr size_t WS_OG = WS_H;
constexpr size_t WS_LS = WS_H + 24 * MiB;
constexpr size_t WS_MG = WS_QA;
constexpr int CW_BAR = 4096;
constexpr int CW_ECNT = 65536;
constexpr int LIST_CAP = 16384;
constexpr int MW_CNT = 16, MW_TB = 48, MW_N2 = 96;
constexpr int RING_BYTES = 131072;
constexpr int LDS_BYTES = 160 * 1024;
constexpr int MISC_OFF = LDS_BYTES - 512;
struct Args { const void* in[25]; float* out; unsigned char* ws; const float* xin; int ph_lo, ph_hi, bar_region, flags; };
static_assert(sizeof(Args) == 25 * 8 + 8 + 8 + 8 + 16, "Args has no padding");
enum { IN_X = 0, IN_C, IN_POS, IN_WADA, IN_BADA, IN_WIN, IN_QNA, IN_KNA, IN_LQ1, IN_LK1, IN_LQ2, IN_LK2, IN_SUBLN, IN_QNB, IN_KNB, IN_WPA, IN_WPB, IN_WO, IN_WR1, IN_BR1, IN_WR2, IN_BR2, IN_WG, IN_WU, IN_WD };

__device__ __forceinline__ int lane_id() { int x; asm volatile("v_mbcnt_lo_u32_b32 %0, -1, 0\n\tv_mbcnt_hi_u32_b32 %0, -1, %0" : "=v"(x)); return x; }
__device__ __forceinline__ float wave_sum(float v) {
#pragma unroll
    for (int o = 1; o < 64; o <<= 1) v += __shfl_xor(v, o);
    return v;
}
__device__ __forceinline__ void transpose_item(const float* W, int K, int N, bf16* WT, int dst_row0, int k0, int n0, LAS float* scr, int lane, int ldk = 0, int kofs = 0) {
    if (ldk == 0) ldk = K; (void)K;
#pragma unroll 8
    for (int i = 0; i < 32; ++i) { const int kk = 2 * i + (lane >> 5); scr[kk * 33 + (lane & 31)] = W[(size_t)(k0 + kk) * N + n0 + (lane & 31)]; }
    LDS_WAIT(); asm volatile("" ::: "memory");
    const int c = lane & 7;
#pragma unroll
    for (int j = 0; j < 4; ++j) { const int n = (lane >> 3) + 8 * j; const LAS float* s = scr + (8 * c) * 33 + n;
        v4u o; o.x = pk2(s[0 * 33], s[1 * 33]); o.y = pk2(s[2 * 33], s[3 * 33]); o.z = pk2(s[4 * 33], s[5 * 33]); o.w = pk2(s[6 * 33], s[7 * 33]);
        *(GAS v4u*)(WT + (size_t)(dst_row0 + n) * ldk + kofs + k0 + 8 * c) = o; }
    LDS_WAIT(); asm volatile("" ::: "memory");
}
__device__ __forceinline__ void convert_layer(const Args& a, int l, LAS unsigned char* lds, int gw, int NGW, int wave, int lane) {
    LAS float* scr = (LAS float*)(lds + wave * 16384);
    unsigned char* ws = a.ws;
    constexpr int I_IN = (D / 64) * (INW / 32), I_PA = (512 / 64) * (D / 32), I_PB = (256 / 64) * (D / 32), I_O = (D / 64) * (D / 32);
    constexpr int I_G = (D / 64) * (DEXP / 32), I_D = (DEXP / 64) * (D / 32);
    constexpr int I_E = 2 * I_G + I_D;
    constexpr int NITEMS = I_IN + I_PA + I_PB + I_O + NEXP * I_E;
    for (int it = gw; it < NITEMS; it += NGW) {
        int r = it;
        if (r < I_IN) { const int nblk = INW / 32, kb = r / nblk, nb = r % nblk, n0 = nb * 32;
            int dst;
            if (n0 < 3840) dst = (n0 & ~255) + 128 * ((n0 >> 5) & 1) + 32 * ((n0 >> 6) & 3);
            else { const int c = (n0 - 3840) & 1023, which = (n0 - 3840) >> 10; dst = (15 + (c >> 7)) * 256 + 128 * which + (c & 127); }
            transpose_item((const float*)a.in[IN_WIN] + (size_t)l * D * INW, D, INW, (bf16*)(ws + WS_WIN), dst, kb * 64, n0, scr, lane); continue; }
        r -= I_IN;
        if (r < I_PA) { const int nblk = D / 32, kb = r / nblk, nb = r % nblk;
            transpose_item((const float*)a.in[IN_WPA] + (size_t)l * 512 * D, 512, D, (bf16*)(ws + WS_WPAB), nb * 32, kb * 64, nb * 32, scr, lane, 768, 0); continue; }
        r -= I_PA;
        if (r < I_PB) { const int nblk = D / 32, kb = r / nblk, nb = r % nblk;
            transpose_item((const float*)a.in[IN_WPB] + (size_t)l * 256 * D, 256, D, (bf16*)(ws + WS_WPAB), nb * 32, kb * 64, nb * 32, scr, lane, 768, 512); continue; }
        r -= I_PB;
        if (r < I_O) { const int nblk = D / 32, kb = r / nblk, nb = r % nblk;
            transpose_item((const float*)a.in[IN_WO] + (size_t)l * D * D, D, D, (bf16*)(ws + WS_WO), nb * 32, kb * 64, nb * 32, scr, lane); continue; }
        r -= I_O;
        const int e = r / I_E; r -= e * I_E;
        if (r < 2 * I_G) { const int up = r >= I_G; if (up) r -= I_G; const int nblk = DEXP / 32, kb = r / nblk, nb = r % nblk, n0 = nb * 32;
            const float* W = (const float*)a.in[up ? IN_WU : IN_WG] + ((size_t)l * NEXP + e) * D * DEXP;
            transpose_item(W, D, DEXP, (bf16*)(ws + WS_WGU), e * 512 + 256 * (n0 >> 7) + (n0 & 127) + (up ? 128 : 0), kb * 64, n0, scr, lane); continue; }
        r -= 2 * I_G;
        { const int nblk = D / 32, kb = r / nblk, nb = r % nblk;
          transpose_item((const float*)a.in[IN_WD] + ((size_t)l * NEXP + e) * DEXP * D, DEXP, D, (bf16*)(ws + WS_WDN), e * 1024 + nb * 32, kb * 64, nb * 32, scr, lane); }
    }
}
__device__ __forceinline__ void prologue_small(const Args& a, LAS unsigned char* lds, int vcu, int G, int wave, int lane, int tid) {
    float* mod = (float*)(a.ws + WS_MOD);
    const float* c = (const float*)a.in[IN_C];
    LAS float* red = (LAS float*)(lds + 8 * 16384);
    for (int it = vcu; it < DEPTH * 96; it += G) {
        const int l = it / 96, ng = it % 96;
        const float* w = (const float*)a.in[IN_WADA] + (size_t)l * D * 6 * D + ng * 64 + lane;
        float a0 = 0.f, a1 = 0.f;
#pragma unroll 8
        for (int k = wave * 128; k < wave * 128 + 128; ++k) { const float wv = w[(size_t)k * 6 * D]; const float c0 = c[k], c1 = c[D + k];
            a0 += (c0 / (1.f + __expf(-c0))) * wv; a1 += (c1 / (1.f + __expf(-c1))) * wv; }
        red[(wave * 2 + 0) * 64 + lane] = a0; red[(wave * 2 + 1) * 64 + lane] = a1;
        __syncthreads();
        if (wave < 2) { float s = 0.f;
#pragma unroll
            for (int ww = 0; ww < 8; ++ww) s += red[(ww * 2 + wave) * 64 + lane];
            mod[((size_t)l * NB + wave) * 6 * D + ng * 64 + lane] = s + ((const float*)a.in[IN_BADA])[l * 6 * D + ng * 64 + lane]; }
        __syncthreads();
    }
    if (vcu == 0 && tid < DEPTH) { const int l = tid; float s1 = 0.f, s2 = 0.f;
        const float* q1 = (const float*)a.in[IN_LQ1] + l * 64; const float* k1 = (const float*)a.in[IN_LK1] + l * 64;
        const float* q2 = (const float*)a.in[IN_LQ2] + l * 64; const float* k2 = (const float*)a.in[IN_LK2] + l * 64;
        for (int k = 0; k < 64; ++k) { s1 += q1[k] * k1[k]; s2 += q2[k] * k2[k]; }
        const float li = 0.8f - 0.6f * (float)exp(-0.3 * (double)l);
        mod[DEPTH * NB * 6 * D + 4 * l] = expf(s1) - expf(s2) + li; mod[DEPTH * NB * 6 * D + 4 * l + 1] = li;
        float ga = 0.f, gb = 0.f, gc = 0.f, gd = 0.f;
        for (int k = 0; k < 64; ++k) { ga = fmaxf(ga, fabsf(((const float*)a.in[IN_QNA])[l * 64 + k])); gb = fmaxf(gb, fabsf(((const float*)a.in[IN_KNA])[l * 64 + k]));
                                       gc = fmaxf(gc, fabsf(((const float*)a.in[IN_QNB])[l * 64 + k])); gd = fmaxf(gd, fabsf(((const float*)a.in[IN_KNB])[l * 64 + k])); }
        mod[DEPTH * NB * 6 * D + 4 * l + 2] = -8.0f * 1.4426950408889634f * ga * gb; mod[DEPTH * NB * 6 * D + 4 * l + 3] = -8.0f * 1.4426950408889634f * gc * gd; }
    { float* cs = (float*)(a.ws + WS_CS); const int* pos = (const int*)a.in[IN_POS];
      const int j = tid & 31; const float inv = (float)pow(10000.0, -(double)(2 * j) / 64.0);
      for (int t = vcu * 16 + (tid >> 5); t < T; t += G * 16) { const float ang = (float)pos[t] * inv;
          cs[(size_t)t * 64 + j] = (float)cos((double)ang); cs[(size_t)t * 64 + 32 + j] = (float)sin((double)ang); } }
}
__device__ __forceinline__ void norm_rows(const float* X, const float* modl  , int shift_off, int scale_off, bf16* H, int gw, int NGW, int lane) {
    for (int m = gw; m < T; m += NGW) {
        const GAS f32x4* xr = (const GAS f32x4*)(X + (size_t)m * D) + lane;
        f32x4 v[4]; float ss = 0.f;
#pragma unroll
        for (int j = 0; j < 4; ++j) { v[j] = xr[64 * j]; ss += (v[j].x * v[j].x + v[j].y * v[j].y) + (v[j].z * v[j].z + v[j].w * v[j].w); }
        const float r = 1.0f / sqrtf(wave_sum(ss) * (1.f / D) + EPS);
        const float* mb = modl + (size_t)(m / S) * 6 * D;
        GAS unsigned long long* o8 = (GAS unsigned long long*)(H + (size_t)m * D) + lane;
#pragma unroll
        for (int j = 0; j < 4; ++j) { const f32x4 sc = *((const f32x4*)(mb + scale_off) + lane + 64 * j), sh = *((const f32x4*)(mb + shift_off) + lane + 64 * j);
            const float y0 = v[j].x * r * (1.f + sc.x) + sh.x, y1 = v[j].y * r * (1.f + sc.y) + sh.y, y2 = v[j].z * r * (1.f + sc.z) + sh.z, y3 = v[j].w * r * (1.f + sc.w) + sh.w;
            o8[64 * j] = (unsigned long long)pk2(y0, y1) | ((unsigned long long)pk2(y2, y3) << 32); }
    }
}
struct EpiG1 {
    static constexpr bool PERM = true, AFTER_DRAIN = false; static constexpr int MID_T = -1;
    unsigned char* ws; const float* cs; const float* qna; const float* kna; const float* qnb; const float* knb;
    __device__ __forceinline__ void operator()(const pg8::f32x4 (&acc)[2][2][4][2], const pg8::Unit& u, int wr, int wc, int fr_, int fq_) const {
        (void)fr_; (void)fq_; const int ln_ = lane_id(); const int fr = ln_ & 15, fq = ln_ >> 4;
        const int pn = u.pn;
        int mode, ld, ct; size_t off; const float* gain = nullptr; float qs = 1.f;
        if (pn < 2) { mode = 0; off = WS_QA; ld = 512; ct = pn; gain = qna; qs = C2; }
        else if (pn < 4) { mode = 0; off = WS_KA; ld = 512; ct = pn - 2; gain = kna; }
        else if (pn < 6) { mode = 1; off = WS_VA; ld = 512; ct = pn - 4; }
        else if (pn < 9) { mode = 0; off = WS_QB; ld = 768; ct = pn - 6; gain = qnb; qs = C2; }
        else if (pn < 12) { mode = 0; off = WS_KB; ld = 768; ct = pn - 9; gain = knb; }
        else if (pn < 15) { mode = 1; off = WS_VB; ld = 768; ct = pn - 12; }
        else { mode = 2; off = WS_GA; ld = 1024; ct = pn - 15; }
        bf16* dst = (bf16*)(ws + off) + ct * 256 + 64 * wc + 8 * fq;
        const int row0 = u.pm * 256 + wr * 64 + fr;
        if (mode == 0) {
            float g1[8], g2[8];
#pragma unroll
            for (int j = 0; j < 8; ++j) { g1[j] = gain[8 * fq + j] * qs; g2[j] = gain[32 + 8 * fq + j] * qs; }
#pragma unroll
            for (int ai = 0; ai < 2; ++ai)
#pragma unroll
                for (int m = 0; m < 4; ++m) {
                    const int r = row0 + ai * 128 + m * 16;
                    float x1[8], x2[8]; float ss = 0.f;
#pragma unroll
                    for (int n = 0; n < 2; ++n)
#pragma unroll
                        for (int i = 0; i < 4; ++i) { x1[4 * n + i] = acc[ai][0][m][n][i]; x2[4 * n + i] = acc[ai][1][m][n][i]; ss += x1[4 * n + i] * x1[4 * n + i] + x2[4 * n + i] * x2[4 * n + i]; }
                    ss += __shfl_xor(ss, 16); ss += __shfl_xor(ss, 32);
                    const float rinv = __builtin_amdgcn_rsqf(ss * (1.f / 64) + EPS);
                    const pg8::f32x4 c0 = *(const pg8::f32x4*)(cs + (size_t)r * 64 + 8 * fq), c1 = *(const pg8::f32x4*)(cs + (size_t)r * 64 + 8 * fq + 4);
                    const pg8::f32x4 s0 = *(const pg8::f32x4*)(cs + (size_t)r * 64 + 32 + 8 * fq), s1 = *(const pg8::f32x4*)(cs + (size_t)r * 64 + 32 + 8 * fq + 4);
                    const float co[8] = {c0[0], c0[1], c0[2], c0[3], c1[0], c1[1], c1[2], c1[3]}, si[8] = {s0[0], s0[1], s0[2], s0[3], s1[0], s1[1], s1[2], s1[3]};
                    float o1[8], o2[8];
#pragma unroll
                    for (int j = 0; j < 8; ++j) { const float y1 = x1[j] * rinv * g1[j], y2 = x2[j] * rinv * g2[j]; o1[j] = y1 * co[j] - y2 * si[j]; o2[j] = y2 * co[j] + y1 * si[j]; }
                    pg8::u32x4 w1, w2;
                    w1.x = pg8::cvt_pk_bf16(o1[0], o1[1]); w1.y = pg8::cvt_pk_bf16(o1[2], o1[3]); w1.z = pg8::cvt_pk_bf16(o1[4], o1[5]); w1.w = pg8::cvt_pk_bf16(o1[6], o1[7]);
                    w2.x = pg8::cvt_pk_bf16(o2[0], o2[1]); w2.y = pg8::cvt_pk_bf16(o2[2], o2[3]); w2.z = pg8::cvt_pk_bf16(o2[4], o2[5]); w2.w = pg8::cvt_pk_bf16(o2[6], o2[7]);
                    *(pg8::u32x4*)(dst + (size_t)r * ld) = w1; *(pg8::u32x4*)(dst + (size_t)r * ld + 32) = w2;
                }
        } else if (mode == 1) {
#pragma unroll
            for (int ai = 0; ai < 2; ++ai)
#pragma unroll
                for (int m = 0; m < 4; ++m) {
                    const int r = row0 + ai * 128 + m * 16;
#pragma unroll
                    for (int bj = 0; bj < 2; ++bj) {
                        const pg8::f32x4 v0 = acc[ai][bj][m][0], v1 = acc[ai][bj][m][1];
                        pg8::u32x4 w; w.x = pg8::cvt_pk_bf16(v0[0], v0[1]); w.y = pg8::cvt_pk_bf16(v0[2], v0[3]); w.z = pg8::cvt_pk_bf16(v1[0], v1[1]); w.w = pg8::cvt_pk_bf16(v1[2], v1[3]);
                        *(pg8::u32x4*)(dst + (size_t)r * ld + 32 * bj) = w;
                    }
                }
        } else {
            bf16* dga = (bf16*)(ws + WS_GA) + ct * 128 + 32 * wc + 8 * fq; bf16* dgb = (bf16*)(ws + WS_GB) + ct * 128 + 32 * wc + 8 * fq;
#pragma unroll
            for (int ai = 0; ai < 2; ++ai)
#pragma unroll
                for (int m = 0; m < 4; ++m) {
                    const int r = row0 + ai * 128 + m * 16;
                    float ra[8], sb[8];
#pragma unroll
                    for (int j = 0; j < 8; ++j) { const float ga_ = acc[ai][0][m][j >> 2][j & 3], gb_ = fmaxf(acc[ai][1][m][j >> 2][j & 3], -30.0f);
                        const float eb = 1.0f + __expf(-gb_); sb[j] = __builtin_amdgcn_rcpf(eb); ra[j] = __builtin_amdgcn_rcpf(1.0f + __expf(-ga_)) * eb; }
                    pg8::u32x4 w1, w2;
                    w1.x = pg8::cvt_pk_bf16(ra[0], ra[1]); w1.y = pg8::cvt_pk_bf16(ra[2], ra[3]); w1.z = pg8::cvt_pk_bf16(ra[4], ra[5]); w1.w = pg8::cvt_pk_bf16(ra[6], ra[7]);
                    w2.x = pg8::cvt_pk_bf16(sb[0], sb[1]); w2.y = pg8::cvt_pk_bf16(sb[2], sb[3]); w2.z = pg8::cvt_pk_bf16(sb[4], sb[5]); w2.w = pg8::cvt_pk_bf16(sb[6], sb[7]);
                    *(pg8::u32x4*)(dga + (size_t)r * 1024) = w1; *(pg8::u32x4*)(dgb + (size_t)r * 1024) = w2;
                }
        }
    }
};

__device__ __forceinline__ void unpack8(const pg8::u32x4 w, float (&f)[8]) {
    f[0] = __uint_as_float(w.x << 16); f[1] = __uint_as_float(w.x & 0xffff0000u); f[2] = __uint_as_float(w.y << 16); f[3] = __uint_as_float(w.y & 0xffff0000u);
    f[4] = __uint_as_float(w.z << 16); f[5] = __uint_as_float(w.z & 0xffff0000u); f[6] = __uint_as_float(w.w << 16); f[7] = __uint_as_float(w.w & 0xffff0000u);
}
struct EpiG2 {
    static constexpr bool PERM = true, AFTER_DRAIN = false; static constexpr int MID_T = 8;
    const bf16* ratio; const bf16* sgb; bf16* mg;
    __device__ __forceinline__ void mid(pg8::f32x4 (&acc)[2][2][4][2], const pg8::Unit& u, int wr, int wc) const {
        const int ln_ = lane_id(); const int fr = ln_ & 15, fq = ln_ >> 4;
        const int row0 = u.pm * 256 + wr * 64 + fr, col0 = u.pn * 256 + wc * 32 + 8 * fq;
#pragma unroll
        for (int ai = 0; ai < 2; ++ai)
#pragma unroll
            for (int m = 0; m < 4; ++m) {
                const size_t rb = (size_t)(row0 + ai * 128 + m * 16) * 1024 + col0;
#pragma unroll
                for (int bj = 0; bj < 2; ++bj) { float g[8]; unpack8(*(const pg8::u32x4*)(ratio + rb + bj * 128), g);
#pragma unroll
                    for (int j = 0; j < 8; ++j) acc[ai][bj][m][j >> 2][j & 3] *= g[j]; }
            }
    }
    __device__ __forceinline__ void operator()(const pg8::f32x4 (&acc)[2][2][4][2], const pg8::Unit& u, int wr, int wc, int fr_, int fq_) const {
        (void)fr_; (void)fq_; const int ln_ = lane_id(); const int fr = ln_ & 15, fq = ln_ >> 4;
        const int row0 = u.pm * 256 + wr * 64 + fr, col0 = u.pn * 256 + wc * 32 + 8 * fq;
#pragma unroll
        for (int ai = 0; ai < 2; ++ai)
#pragma unroll
            for (int m = 0; m < 4; ++m) {
                const size_t rb = (size_t)(row0 + ai * 128 + m * 16) * 1024 + col0;
#pragma unroll
                for (int bj = 0; bj < 2; ++bj) {
                    float g[8]; unpack8(*(const pg8::u32x4*)(sgb + rb + bj * 128), g);
                    float o[8];
#pragma unroll
                    for (int j = 0; j < 8; ++j) o[j] = g[j] * acc[ai][bj][m][j >> 2][j & 3];
                    pg8::u32x4 w; w.x = pg8::cvt_pk_bf16(o[0], o[1]); w.y = pg8::cvt_pk_bf16(o[2], o[3]); w.z = pg8::cvt_pk_bf16(o[4], o[5]); w.w = pg8::cvt_pk_bf16(o[6], o[7]);
                    *(pg8::u32x4*)(mg + rb + bj * 128) = w;
                }
                asm volatile("" ::: "memory");
            }
    }
};
struct EpiG3 {
    static constexpr bool PERM = false, AFTER_DRAIN = false; static constexpr int MID_T = -1;
    const float* xin; float* xout; const float* gate;
    __device__ __forceinline__ void operator()(const pg8::f32x4 (&acc)[2][2][4][2], const pg8::Unit& u, int wr, int wc, int fr_, int fq_) const {
        (void)fr_; (void)fq_; const int ln_ = lane_id(); const int fr = ln_ & 15, fq = ln_ >> 4;
        const int row0 = u.pm * 256 + wr * 64 + fr, col0 = u.pn * 256 + wc * 32 + 4 * fq;
        const float* gb = gate + (size_t)((u.pm * 256) / S) * 6 * D + col0;
        pg8::f32x4 gv[2][2];
#pragma unroll
        for (int bj = 0; bj < 2; ++bj)
#pragma unroll
            for (int n = 0; n < 2; ++n) gv[bj][n] = *(const pg8::f32x4*)(gb + bj * 128 + n * 16);
#pragma unroll
        for (int ai = 0; ai < 2; ++ai)
#pragma unroll
            for (int m = 0; m < 4; ++m) {
                const size_t rb = (size_t)(row0 + ai * 128 + m * 16) * D + col0;
#pragma unroll
                for (int bj = 0; bj < 2; ++bj)
#pragma unroll
                    for (int n = 0; n < 2; ++n) { const pg8::f32x4 xv = *(const pg8::f32x4*)(xin + rb + bj * 128 + n * 16);
                        *(pg8::f32x4*)(xout + rb + bj * 128 + n * 16) = xv + gv[bj][n] * acc[ai][bj][m][n]; }
                if (m & 1) asm volatile("" ::: "memory");
            }
    }
};

template <int M> __device__ __forceinline__ float xor_lane(float x) { return __int_as_float(__builtin_amdgcn_ds_swizzle(__float_as_int(x), (M << 10) | 0x1F)); }
#define N2_LEVEL(v, n, M) do { const bool b_ = (lane & (M)) != 0; _Pragma("unroll") for (int i_ = 0; i_ < (n) / 2; ++i_) { const float keep_ = b_ ? v[i_ + (n) / 2] : v[i_], send_ = b_ ? v[i_] : v[i_ + (n) / 2]; v[i_] = keep_ + xor_lane<M>(send_); } } while (0)
constexpr int N2_LD = 1028;
__device__ __forceinline__ void n2_route(float ve  , float vg  , LAS float* scr, int lane, int m, bool live, float* rtw, LAS int* lent, volatile LAS unsigned* lcnt, volatile LAS unsigned* lnum) {
    if (lane < 32) scr[4 + lane] = ve; if (lane < 4) scr[lane] = vg;
    LDS_WAIT();
    const f32x4 g4 = *(const LAS f32x4*)scr;
    const float mm = fmaxf(fmaxf(g4.x, g4.y), fmaxf(g4.z, g4.w));
    const float p0 = expf(g4.x - mm), p1 = expf(g4.y - mm), p2 = expf(g4.z - mm), p3 = expf(g4.w - mm), sum = ((p0 + p1) + p2) + p3;
    int gi = 0; float pbest = p0 / sum;
    { const float q1 = p1 / sum, q2 = p2 / sum, q3 = p3 / sum; if (q1 > pbest) { pbest = q1; gi = 1; } if (q2 > pbest) { pbest = q2; gi = 2; } if (q3 > pbest) { pbest = q3; gi = 3; } }
    const f32x4 ea = *(const LAS f32x4*)(scr + 4 + gi * 8), eb = *(const LAS f32x4*)(scr + 8 + gi * 8);
    const float ig[8] = {ea.x, ea.y, ea.z, ea.w, eb.x, eb.y, eb.z, eb.w};
    int i0 = 0; float b0 = ig[0];
#pragma unroll
    for (int e = 1; e < 8; ++e) if (ig[e] > b0) { b0 = ig[e]; i0 = e; }
    int i1 = -1; float b1 = -INFINITY;
#pragma unroll
    for (int e = 0; e < 8; ++e) if (e != i0 && (i1 < 0 || ig[e] > b1)) { b1 = ig[e]; i1 = e; }
    const float e1 = expf(b1 - b0);
    if (lane == 0 && live) {
        const int ea_ = gi * 8 + i0, eb_ = gi * 8 + i1;
        rtw[(size_t)m * 2] = pbest / (1.f + e1); rtw[(size_t)m * 2 + 1] = pbest * e1 / (1.f + e1);
        const unsigned pa = __hip_atomic_fetch_add((LAS unsigned*)(lcnt + ea_), 1u, __ATOMIC_RELAXED, __HIP_MEMORY_SCOPE_WORKGROUP), pb = __hip_atomic_fetch_add((LAS unsigned*)(lcnt + eb_), 1u, __ATOMIC_RELAXED, __HIP_MEMORY_SCOPE_WORKGROUP);
        const unsigned n = __hip_atomic_fetch_add((LAS unsigned*)lnum, 2u, __ATOMIC_RELAXED, __HIP_MEMORY_SCOPE_WORKGROUP);
        lent[3 * n] = m * 2; lent[3 * n + 1] = ea_; lent[3 * n + 2] = (int)pa;
        lent[3 * n + 3] = m * 2 + 1; lent[3 * n + 4] = eb_; lent[3 * n + 5] = (int)pb;
    }
    LDS_WAIT();
}
__device__ __forceinline__ void n2_rows(const Args& a, int l, const float* X, const float* modl, LAS unsigned char* lds, volatile LAS unsigned* MISC, int vcu, int G, int wave, int lane) {
    LAS float* Wl = (LAS float*)lds;
    const float* wr1 = (const float*)a.in[IN_WR1] + (size_t)l * D * 4; const float* wr2 = (const float*)a.in[IN_WR2] + (size_t)l * D * 32;
    const int tid = wave * 64 + lane;
#pragma unroll 1
    for (int i0 = 0; i0 < 64; i0 += 16) { float t_[16];
#pragma unroll
        for (int i = 0; i < 16; ++i) t_[i] = wr2[tid + NTHR * (i0 + i)];
#pragma unroll
        for (int i = 0; i < 16; ++i) { const int idx = tid + NTHR * (i0 + i); Wl[(4 + (idx & 31)) * N2_LD + (idx >> 5)] = t_[i]; } }
    { float t_[8];
#pragma unroll
      for (int i = 0; i < 8; ++i) t_[i] = wr1[tid + NTHR * i];
#pragma unroll
      for (int i = 0; i < 8; ++i) { const int idx = tid + NTHR * i; Wl[(idx & 3) * N2_LD + (idx >> 2)] = t_[i]; } }
    LAS int* lent = (LAS int*)(lds + 36 * N2_LD * 4);
    LAS float* scr = (LAS float*)(lds + MISC_OFF - 2048) + wave * 64;
    volatile LAS unsigned* lcnt = MISC + MW_CNT;
    volatile LAS unsigned* lnum = MISC + MW_N2;
    if (tid < 32) lcnt[tid] = 0u; if (tid == 32) lnum[0] = 0u;
    __syncthreads();
    const float bias_e = ((const float*)a.in[IN_BR2])[l * 32 + (lane & 31)], bias_g = ((const float*)a.in[IN_BR1])[l * 4 + (lane & 3)];
    bf16* H = (bf16*)(a.ws + WS_H); float* rtw = (float*)(a.ws + WS_RTW);
    const int gw = vcu * NWAVES + wave, NGW = G * NWAVES;
    for (int m0 = gw; m0 < T; m0 += 2 * NGW) {
        const int m1r = m0 + NGW; const bool live1 = m1r < T; const int m1 = live1 ? m1r : m0;
        f32x4 v0[4], v1[4]; float ss0 = 0.f, ss1 = 0.f;
        { const GAS f32x4* x0 = (const GAS f32x4*)(X + (size_t)m0 * D) + lane; const GAS f32x4* x1 = (const GAS f32x4*)(X + (size_t)m1 * D) + lane;
#pragma unroll
          for (int j = 0; j < 4; ++j) { v0[j] = x0[64 * j]; v1[j] = x1[64 * j]; }
#pragma unroll
          for (int j = 0; j < 4; ++j) { ss0 += (v0[j].x * v0[j].x + v0[j].y * v0[j].y) + (v0[j].z * v0[j].z + v0[j].w * v0[j].w); ss1 += (v1[j].x * v1[j].x + v1[j].y * v1[j].y) + (v1[j].z * v1[j].z + v1[j].w * v1[j].w); } }
        const float r0 = 1.0f / sqrtf(wave_sum(ss0) * (1.f / D) + EPS), r1 = 1.0f / sqrtf(wave_sum(ss1) * (1.f / D) + EPS);
        const float* mb0 = modl + (size_t)(m0 / S) * 6 * D; const float* mb1 = modl + (size_t)(m1 / S) * 6 * D;
        GAS unsigned long long* o0 = (GAS unsigned long long*)(H + (size_t)m0 * D) + lane; GAS unsigned long long* o1 = (GAS unsigned long long*)(H + (size_t)m1 * D) + lane;
#pragma unroll
        for (int j = 0; j < 4; ++j) {
            { const f32x4 sc = *((const f32x4*)(mb0 + 4096) + lane + 64 * j), sh = *((const f32x4*)(mb0 + 3072) + lane + 64 * j);
              v0[j].x = v0[j].x * r0 * (1.f + sc.x) + sh.x; v0[j].y = v0[j].y * r0 * (1.f + sc.y) + sh.y; v0[j].z = v0[j].z * r0 * (1.f + sc.z) + sh.z; v0[j].w = v0[j].w * r0 * (1.f + sc.w) + sh.w;
              o0[64 * j] = (unsigned long long)pk2(v0[j].x, v0[j].y) | ((unsigned long long)pk2(v0[j].z, v0[j].w) << 32); }
            { const f32x4 sc = *((const f32x4*)(mb1 + 4096) + lane + 64 * j), sh = *((const f32x4*)(mb1 + 3072) + lane + 64 * j);
              v1[j].x = v1[j].x * r1 * (1.f + sc.x) + sh.x; v1[j].y = v1[j].y * r1 * (1.f + sc.y) + sh.y; v1[j].z = v1[j].z * r1 * (1.f + sc.z) + sh.z; v1[j].w = v1[j].w * r1 * (1.f + sc.w) + sh.w;
              if (live1) o1[64 * j] = (unsigned long long)pk2(v1[j].x, v1[j].y) | ((unsigned long long)pk2(v1[j].z, v1[j].w) << 32); } }
        float pe0[32], pe1[32], pg0[4], pg1[4];
#pragma unroll
        for (int ob = 0; ob < 36; ob += 4) {
            f32x4 w[4][4];
#pragma unroll
            for (int oo = 0; oo < 4; ++oo)
#pragma unroll
                for (int j = 0; j < 4; ++j) w[oo][j] = *((const LAS f32x4*)(Wl + (ob + oo) * N2_LD) + lane + 64 * j);
#pragma unroll
            for (int oo = 0; oo < 4; ++oo) { float a0 = 0.f, a1 = 0.f;
#pragma unroll
                for (int j = 0; j < 4; ++j) { const f32x4 ww = w[oo][j];
                    a0 = fmaf(v0[j].x, ww.x, a0); a0 = fmaf(v0[j].y, ww.y, a0); a0 = fmaf(v0[j].z, ww.z, a0); a0 = fmaf(v0[j].w, ww.w, a0);
                    a1 = fmaf(v1[j].x, ww.x, a1); a1 = fmaf(v1[j].y, ww.y, a1); a1 = fmaf(v1[j].z, ww.z, a1); a1 = fmaf(v1[j].w, ww.w, a1); }
                const int o = ob + oo;
                if (o < 4) { pg0[o] = a0; pg1[o] = a1; } else { pe0[o - 4] = a0; pe1[o - 4] = a1; } }
        }
        N2_LEVEL(pe0, 32, 16); N2_LEVEL(pe1, 32, 16); N2_LEVEL(pe0, 16, 8); N2_LEVEL(pe1, 16, 8); N2_LEVEL(pe0, 8, 4); N2_LEVEL(pe1, 8, 4);
        N2_LEVEL(pe0, 4, 2); N2_LEVEL(pe1, 4, 2); N2_LEVEL(pe0, 2, 1); N2_LEVEL(pe1, 2, 1);
        N2_LEVEL(pg0, 4, 2); N2_LEVEL(pg1, 4, 2); N2_LEVEL(pg0, 2, 1); N2_LEVEL(pg1, 2, 1);
        float e0 = pe0[0], e1 = pe1[0], g0 = pg0[0], g1 = pg1[0];
        g0 += xor_lane<4>(g0); g1 += xor_lane<4>(g1); g0 += xor_lane<8>(g0); g1 += xor_lane<8>(g1); g0 += xor_lane<16>(g0); g1 += xor_lane<16>(g1);
        e0 += __shfl_xor(e0, 32); e1 += __shfl_xor(e1, 32); g0 += __shfl_xor(g0, 32); g1 += __shfl_xor(g1, 32);
        n2_route(e0 + bias_e, g0 + bias_g, scr, lane, m0, true, rtw, lent, lcnt, lnum);
        n2_route(e1 + bias_e, g1 + bias_g, scr, lane, m1, live1, rtw, lent, lcnt, lnum);
    }
    __syncthreads();
    gu32* ecnt = (gu32*)(a.ws + WS_CTL) + CW_ECNT + l * 32 * 16;
    if (tid < 32) { const unsigned c = lcnt[tid]; lcnt[tid] = c ? __hip_atomic_fetch_add(ecnt + tid * 16, c, RLX_AGENT) : 0u; }
    __syncthreads();
    int* list = (int*)(a.ws + WS_LIST);
    const int n = (int)lnum[0];
    for (int i = tid; i < n; i += NTHR) { const int e = lent[3 * i + 1]; list[e * LIST_CAP + (int)lcnt[e] + lent[3 * i + 2]] = lent[3 * i]; }
    __syncthreads();
}
#undef N2_LEVEL
__device__ __forceinline__ void moe_tables(const Args& a, int l, volatile LAS unsigned* MISC, int wave, int lane) {
    __syncthreads();
    if (wave == 0) {
        const gu32* ecnt = (const gu32*)(a.ws + WS_CTL) + CW_ECNT + l * 32 * 16;
        unsigned c = lane < 32 ? __hip_atomic_load(ecnt + lane * 16, RLX_AGENT) : 0u;
        if (c > (unsigned)LIST_CAP) c = LIST_CAP;
        unsigned tl = (c + 255u) >> 8, inc = tl;
#pragma unroll
        for (int o = 1; o < 32; o <<= 1) { const unsigned y = __shfl_up(inc, o); if (lane >= o) inc += y; }
        if (lane < 32) { MISC[MW_CNT + lane] = c; MISC[MW_TB + lane] = inc - tl; }
        if (lane == 31) MISC[MW_TB + 32] = inc;
    }
    __syncthreads();
}
struct MoeSched {
    volatile LAS unsigned* MISC; const int* list; int npn, G, c; bool g4;
    __device__ __forceinline__ bool next(int i, pg8::Unit& u) const {
        const int L = i * G + c; const int nt = (int)MISC[MW_TB + 32];
        if (L >= nt * npn) return false;
        const int ct = L / npn, pnl = L - ct * npn;
        int e = 0;
        for (int k = 16; k >= 1; k >>= 1) if (e + k < 32 && (int)MISC[MW_TB + e + k] <= ct) e += k;
        const int rt = ct - (int)MISC[MW_TB + e];
        if (g4) { u.pm = e * 64 + rt; u.pn = e * 2 + pnl; } else { u.pm = ct; u.pn = e * 4 + pnl; }
        return true;
    }
    __device__ __forceinline__ int a_row(const pg8::Unit& u, int r) const { const int e = u.pm >> 6, ri = (u.pm & 63) * 256 + r; return ri < (int)MISC[MW_CNT + e] ? (list[e * LIST_CAP + ri] >> 1) : 0; }
    __device__ __forceinline__ void a_ready(const pg8::Unit&) const {}
    __device__ __forceinline__ void done(const pg8::Unit&) const {}
};
struct EpiG4 {
    static constexpr bool PERM = true, AFTER_DRAIN = false; static constexpr int MID_T = -1;
    bf16* hid; volatile LAS unsigned* MISC;
    __device__ __forceinline__ void operator()(const pg8::f32x4 (&acc)[2][2][4][2], const pg8::Unit& u, int wr, int wc, int fr_, int fq_) const {
        (void)fr_; (void)fq_; const int ln_ = lane_id(); const int fr = ln_ & 15, fq = ln_ >> 4;
        const int e = u.pm >> 6, ct = (int)MISC[MW_TB + e] + (u.pm & 63), pnl = u.pn & 1;
        bf16* dst = hid + (size_t)(ct * 256 + wr * 64 + fr) * DEXP + pnl * 128 + wc * 32 + 8 * fq;
#pragma unroll
        for (int ai = 0; ai < 2; ++ai)
#pragma unroll
            for (int m = 0; m < 4; ++m) { float o[8];
#pragma unroll
                for (int j = 0; j < 8; ++j) { const float gv = acc[ai][0][m][j >> 2][j & 3], uv = acc[ai][1][m][j >> 2][j & 3]; o[j] = gv * __builtin_amdgcn_rcpf(1.0f + __expf(-gv)) * uv; }
                pg8::u32x4 w; w.x = pg8::cvt_pk_bf16(o[0], o[1]); w.y = pg8::cvt_pk_bf16(o[2], o[3]); w.z = pg8::cvt_pk_bf16(o[4], o[5]); w.w = pg8::cvt_pk_bf16(o[6], o[7]);
                *(pg8::u32x4*)(dst + (size_t)(ai * 128 + m * 16) * DEXP) = w; }
    }
};
struct EpiG5 {
    static constexpr bool PERM = true, AFTER_DRAIN = false; static constexpr int MID_T = -1;
    bf16* Y; const int* list; const float* rtw; volatile LAS unsigned* MISC;
    __device__ __forceinline__ void operator()(const pg8::f32x4 (&acc)[2][2][4][2], const pg8::Unit& u, int wr, int wc, int fr_, int fq_) const {
        (void)fr_; (void)fq_; const int ln_ = lane_id(); const int fr = ln_ & 15, fq = ln_ >> 4;
        const int e = u.pn >> 2, pnl = u.pn & 3, rt = u.pm - (int)MISC[MW_TB + e], cnt = (int)MISC[MW_CNT + e];
        const int col0 = pnl * 256 + wc * 32 + 8 * fq;
#pragma unroll
        for (int ai = 0; ai < 2; ++ai)
#pragma unroll
            for (int m = 0; m < 4; ++m) { const int ri = rt * 256 + ai * 128 + wr * 64 + m * 16 + fr;
                if (ri < cnt) { const int ent = list[e * LIST_CAP + ri]; const float w = rtw[ent];
#pragma unroll
                    for (int bj = 0; bj < 2; ++bj) { const pg8::f32x4 v0 = acc[ai][bj][m][0] * w, v1 = acc[ai][bj][m][1] * w;
                        pg8::u32x4 q; q.x = pg8::cvt_pk_bf16(v0[0], v0[1]); q.y = pg8::cvt_pk_bf16(v0[2], v0[3]); q.z = pg8::cvt_pk_bf16(v1[0], v1[1]); q.w = pg8::cvt_pk_bf16(v1[2], v1[3]);
                        *(pg8::u32x4*)(Y + (size_t)ent * D + col0 + bj * 128) = q; } }
                asm volatile("" ::: "memory"); }
    }
};
__device__ __forceinline__ void combine_rows(const float* X1, const bf16* Y, const float* modl, float* Xo, int gw, int NGW, int lane) {
    for (int m = gw; m < T; m += NGW) {
        const float* gb = modl + (size_t)(m / S) * 6 * D + 5120;
#pragma unroll
        for (int j = 0; j < 2; ++j) { const int c0 = 8 * lane + 512 * j;
            float y0[8], y1[8]; unpack8(*(const pg8::u32x4*)(Y + (size_t)(2 * m) * D + c0), y0); unpack8(*(const pg8::u32x4*)(Y + (size_t)(2 * m + 1) * D + c0), y1);
            const f32x4 xa = *(const f32x4*)(X1 + (size_t)m * D + c0), xb = *(const f32x4*)(X1 + (size_t)m * D + c0 + 4);
            const f32x4 ga = *(const f32x4*)(gb + c0), gbv = *(const f32x4*)(gb + c0 + 4);
            f32x4 oa, ob;
            oa.x = xa.x + ga.x * (y0[0] + y1[0]); oa.y = xa.y + ga.y * (y0[1] + y1[1]); oa.z = xa.z + ga.z * (y0[2] + y1[2]); oa.w = xa.w + ga.w * (y0[3] + y1[3]);
            ob.x = xb.x + gbv.x * (y0[4] + y1[4]); ob.y = xb.y + gbv.y * (y0[5] + y1[5]); ob.z = xb.z + gbv.z * (y0[6] + y1[6]); ob.w = xb.w + gbv.w * (y0[7] + y1[7]);
            *(f32x4*)(Xo + (size_t)m * D + c0) = oa; *(f32x4*)(Xo + (size_t)m * D + c0 + 4) = ob; }
    }
}
}
namespace atA {
using bf16x8 = __attribute__((ext_vector_type(8))) short;
using s16x4 = __attribute__((ext_vector_type(4))) short;
using f32x16 = __attribute__((ext_vector_type(16))) float;
using u32x4 = __attribute__((ext_vector_type(4))) unsigned;
typedef __attribute__((address_space(3))) const char* lds_cptr;
typedef short v4i16_t __attribute__((ext_vector_type(4)));
typedef float f32x2_t __attribute__((ext_vector_type(2))); typedef __bf16 bf16x2_t __attribute__((ext_vector_type(2)));
constexpr int S = 8192, NT = S / 64, QP = 512, OP = 768;
constexpr int SLOT = 16384, LDS_K = 0, LDS_V = 3 * SLOT, LDS_WS = 6 * SLOT, LDS_X = 0;
__device__ __forceinline__ int crow(int r, int hi) { return (r & 3) + 8 * (r >> 2) + 4 * hi; }
__device__ __forceinline__ void glds16(const void* gsrc, unsigned lds_dst) { unsigned keep;
    asm volatile("s_mov_b32 %0, m0\n\ts_mov_b32 m0, %2\n\ts_nop 0\n\tglobal_load_lds_dwordx4 %1, off\n\ts_mov_b32 m0, %0" : "=&s"(keep) : "v"(gsrc), "s"(lds_dst) : "memory"); }
__device__ __forceinline__ unsigned cvtpk_s(float lo, float hi) { f32x2_t v = {lo, hi}; bf16x2_t b = __builtin_convertvector(v, bf16x2_t); return __builtin_bit_cast(unsigned, b); }
__device__ __forceinline__ s16x4 vtr(lds_cptr p) { return __builtin_bit_cast(s16x4, __builtin_amdgcn_ds_read_tr16_b64_v4i16((__attribute__((address_space(3))) v4i16_t*)p)); }
__device__ __forceinline__ bf16x8 kld(lds_cptr p) { return *(const __attribute__((address_space(3))) bf16x8*)p; }
#define ATA_WAIT_BAR(N) asm volatile("s_waitcnt vmcnt(" #N ") lgkmcnt(0)\n\ts_barrier" ::: "memory")
#define ATA_MFMA(a, b, c) __builtin_amdgcn_mfma_f32_32x32x16_bf16(a, b, c, 0, 0, 0)
#define ATA_SBAR() __builtin_amdgcn_sched_barrier(0)
#define ATA_PIN(x) asm volatile("" : "+v"(x))

struct Params { const unsigned short* Q; const unsigned short* K; const unsigned short* V; unsigned short* O; float negM, lam, one_minus_li; const float* subln; };

template <int VAR>
__device__ __forceinline__ void unit(const Params& P, int b, int h, int qb, char* shm, int wid) {
    int lane_; asm volatile("v_mbcnt_lo_u32_b32 %0, -1, 0\n\tv_mbcnt_hi_u32_b32 %0, -1, %0" : "=v"(lane_));
    const int lane = lane_, r32 = lane & 31, hi = lane >> 5, mp = wid >> 2, wq = wid & 3;
    const long rowbase = (long)b * S; const int q0 = qb * 128 + wq * 32;
    const unsigned lds0 = (unsigned)(uintptr_t)shm;
    float* wsf = (float*)(shm + LDS_WS) + wid * 64;
    const int dkey = 8 * wid + (lane >> 3), dsl = lane & 7;
    const unsigned short* ksrc0 = P.K + (rowbase + dkey) * QP + (2 * h + 0) * 64 + ((dsl ^ ((dkey >> 1) & 7)) * 8);
    const unsigned short* ksrc1 = ksrc0 + 64;
    const unsigned short* vsrcA = P.V + (rowbase + dkey) * QP + h * 128 + (((dsl >> 2) ^ ((dkey >> 1) & 1)) * 32) + (dsl & 3) * 8;
    const unsigned short* vsrcB = vsrcA + 64;
    const unsigned kdst = lds0 + LDS_K + wid * 1024, vdst = lds0 + LDS_V + wid * 1024;
#define DMA_K(t, slot) do { if (VAR == 1 || VAR == 3) break; glds16(ksrc0 + (long)(t) * 64 * QP, (unsigned)__builtin_amdgcn_readfirstlane(kdst + (slot))); glds16(ksrc1 + (long)(t) * 64 * QP, (unsigned)__builtin_amdgcn_readfirstlane(kdst + (slot) + 8192)); } while (0)
#define DMA_V(t, slot) do { if (VAR == 1 || VAR == 3) break; glds16(vsrcA + (long)(t) * 64 * QP, (unsigned)__builtin_amdgcn_readfirstlane(vdst + (slot))); glds16(vsrcB + (long)(t) * 64 * QP, (unsigned)__builtin_amdgcn_readfirstlane(vdst + (slot) + 8192)); } while (0)
    const lds_cptr shm3 = (lds_cptr)shm;
    lds_cptr kpd[4];
#pragma unroll
    for (int d0 = 0; d0 < 4; ++d0) kpd[d0] = shm3 + LDS_K + mp * 8192 + r32 * 128 + (((2 * d0 + hi) ^ ((r32 >> 1) & 7)) * 16);
    const int vq = (lane & 15) >> 2, vsq = (vq >> 1) & 1;
    const lds_cptr vpA = shm3 + LDS_V + ((lane >> 4) & 1) * 32 + (lane & 3) * 8 + (4 * hi + vq) * 128 + vsq * 64;
    const lds_cptr vpB = shm3 + LDS_V + ((lane >> 4) & 1) * 32 + (lane & 3) * 8 + (4 * hi + vq) * 128 + (vsq ^ 1) * 64;
    DMA_K(0, 0); DMA_V(0, 0); DMA_K(1, SLOT);
    bf16x8 qr[4];
    { const unsigned short* Qw = P.Q + (rowbase + q0) * QP + (2 * h + mp) * 64;
#pragma unroll
      for (int d0 = 0; d0 < 4; ++d0) qr[d0] = *reinterpret_cast<const bf16x8*>(&Qw[(long)r32 * QP + d0 * 16 + hi * 8]); }
    DMA_K(2, 2 * SLOT);
    f32x16 o[4]; o[0] = f32x16{}; o[1] = f32x16{}; o[2] = f32x16{}; o[3] = f32x16{};
    f32x16 negm;
    { float nm = P.negM; asm volatile("" : "+v"(nm));
#pragma unroll
      for (int r = 0; r < 16; ++r) negm[r] = nm; }
    ATA_PIN(negm);
    float l_reg = 0.f;
    bf16x8 kf[8];
    f32x16 pA0, pA1, pB0, pB1;
    ATA_WAIT_BAR(6);
#pragma unroll
    for (int d0 = 0; d0 < 4; ++d0) { kf[2 * d0] = kld(kpd[d0]); kf[2 * d0 + 1] = kld(kpd[d0] + 4096); }
    pA0 = ATA_MFMA(kf[0], qr[0], negm); pA1 = ATA_MFMA(kf[1], qr[0], negm);
#pragma unroll
    for (int d0 = 1; d0 < 4; ++d0) { pA0 = ATA_MFMA(kf[2 * d0], qr[d0], pA0); pA1 = ATA_MFMA(kf[2 * d0 + 1], qr[d0], pA1); }
#pragma unroll
    for (int r = 0; r < 16; ++r) { pA0[r] = __builtin_amdgcn_exp2f(pA0[r]); pA1[r] = __builtin_amdgcn_exp2f(pA1[r]); }
    ATA_WAIT_BAR(0);
    DMA_K(3, 0); DMA_V(1, SLOT);
#pragma unroll
    for (int d0 = 0; d0 < 4; ++d0) { kf[2 * d0] = kld(kpd[d0] + SLOT); kf[2 * d0 + 1] = kld(kpd[d0] + SLOT + 4096); }
    ATA_WAIT_BAR(4);
    int sl_prev = 0, sl_cur = SLOT, sl_next = 2 * SLOT;
#define ROT() do { sl_prev = sl_cur; sl_cur = sl_next; sl_next = (sl_next == 2 * SLOT) ? 0 : sl_next + SLOT; } while (0)
    s16x4 vlo[8], vhi[8]; u32x4 pw0, pw1, pw2, pw3;
    if (VAR == 4) {
#pragma unroll
        for (int i = 0; i < 8; ++i) { vlo[i] = s16x4{1, 2, 3, 4}; vhi[i] = s16x4{5, 6, 7, 8}; ATA_PIN(vlo[i]); ATA_PIN(vhi[i]); } }
#define PKW(Pt, B) cvtpk_s(Pt[B], Pt[B + 1])
#define PAF(k) __builtin_bit_cast(bf16x8, pw##k)
#define VFR(i) (bf16x8){vlo[i][0], vlo[i][1], vlo[i][2], vlo[i][3], vhi[i][0], vhi[i][1], vhi[i][2], vhi[i][3]}
#define VOFF(i) ((((i) >> 3) * 8192) + (((i) & 3) * 2048))
#define VRD(i, s) do { if (VAR == 4) break; vlo[s] = vtr(((((i) >> 2) & 1) ? vpB_ : vpA_) + VOFF(i)); vhi[s] = vtr(((((i) >> 2) & 1) ? vpB_ : vpA_) + VOFF(i) + 1024); } while (0)
#define EX(v) (VAR == 2 ? (v) * 0.5f : __builtin_amdgcn_exp2f(v))
#define GAPA(MF, A0, A1, A2, A3, W0, W1, PW) do { MF; sacc += A0; sacc += A1; sacc += A2; sacc += A3; ATA_PIN(sacc); W0; W1; ATA_PIN(PW); ATA_SBAR(); } while (0)
#define GAPB(MF, X, B) do { MF; X[B] = EX(X[B]); X[B + 1] = EX(X[B + 1]); ATA_PIN(X); ATA_SBAR(); } while (0)
#define KRD(G, j) do { if (G) { kf[j] = kld(kpd[(j) >> 1] + sl_next + ((j) & 1) * 4096); ATA_SBAR(); } } while (0)
#define STEP(C0, C1, P0, P1, t, GK, GV, GL) do { ATA_SBAR(); \
    const lds_cptr vpA_ = vpA + sl_prev, vpB_ = vpB + sl_prev; \
    VRD(0, 0); ATA_SBAR(); float sacc = (P0[0] + P0[1]); \
    GAPA(C0 = ATA_MFMA(kf[0], qr[0], negm), P0[2], P0[3], P0[4], P0[5],     pw0[0] = PKW(P0, 0), pw0[1] = PKW(P0, 2), pw0); \
    VRD(1, 1); ATA_SBAR(); GAPA(C1 = ATA_MFMA(kf[1], qr[0], negm), P0[6], P0[7], P0[8], P0[9],     pw0[2] = PKW(P0, 4), pw0[3] = PKW(P0, 6), pw0); \
    VRD(2, 2); ATA_SBAR(); GAPA(C0 = ATA_MFMA(kf[2], qr[1], C0),   P0[10], P0[11], P0[12], P0[13], pw1[0] = PKW(P0, 8), pw1[1] = PKW(P0, 10), pw1); \
    VRD(3, 3); ATA_SBAR(); GAPA(C1 = ATA_MFMA(kf[3], qr[1], C1),   P0[14], P0[15], P1[0], P1[1],   pw1[2] = PKW(P0, 12), pw1[3] = PKW(P0, 14), pw1); \
    VRD(4, 4); ATA_SBAR(); GAPA(C0 = ATA_MFMA(kf[4], qr[2], C0),   P1[2], P1[3], P1[4], P1[5],     pw2[0] = PKW(P1, 0), pw2[1] = PKW(P1, 2), pw2); \
    VRD(5, 5); ATA_SBAR(); GAPA(C1 = ATA_MFMA(kf[5], qr[2], C1),   P1[6], P1[7], P1[8], P1[9],     pw2[2] = PKW(P1, 4), pw2[3] = PKW(P1, 6), pw2); \
    VRD(6, 6); ATA_SBAR(); GAPA(C0 = ATA_MFMA(kf[6], qr[3], C0),   P1[10], P1[11], P1[12], P1[13], pw3[0] = PKW(P1, 8), pw3[1] = PKW(P1, 10), pw3); \
    VRD(7, 7); ATA_SBAR(); GAPA(C1 = ATA_MFMA(kf[7], qr[3], C1),   P1[14], P1[15], 0.f, 0.f,       pw3[2] = PKW(P1, 12), pw3[3] = PKW(P1, 14), pw3); \
    l_reg += sacc; \
    if (GK) { DMA_K((t) + 3, sl_cur); } if (GV) { DMA_V((t) + 1, sl_next); } \
    ATA_SBAR(); \
    GAPB(o[0] = ATA_MFMA(PAF(0), VFR(0), o[0]), C0, 0);  VRD(8, 0);  ATA_SBAR(); \
    GAPB(o[0] = ATA_MFMA(PAF(1), VFR(1), o[0]), C0, 2);  VRD(9, 1);  ATA_SBAR(); \
    GAPB(o[0] = ATA_MFMA(PAF(2), VFR(2), o[0]), C0, 4);  VRD(10, 2); ATA_SBAR(); \
    GAPB(o[0] = ATA_MFMA(PAF(3), VFR(3), o[0]), C0, 6);  VRD(11, 3); ATA_SBAR(); \
    GAPB(o[1] = ATA_MFMA(PAF(0), VFR(4), o[1]), C0, 8);  VRD(12, 4); ATA_SBAR(); \
    GAPB(o[1] = ATA_MFMA(PAF(1), VFR(5), o[1]), C0, 10); VRD(13, 5); ATA_SBAR(); \
    GAPB(o[1] = ATA_MFMA(PAF(2), VFR(6), o[1]), C0, 12); VRD(14, 6); ATA_SBAR(); \
    GAPB(o[1] = ATA_MFMA(PAF(3), VFR(7), o[1]), C0, 14); VRD(15, 7); ATA_SBAR(); \
    KRD(GL, 0); GAPB(o[2] = ATA_MFMA(PAF(0), VFR(0), o[2]), C1, 0); \
    KRD(GL, 1); GAPB(o[2] = ATA_MFMA(PAF(1), VFR(1), o[2]), C1, 2); \
    KRD(GL, 2); GAPB(o[2] = ATA_MFMA(PAF(2), VFR(2), o[2]), C1, 4); \
    KRD(GL, 3); GAPB(o[2] = ATA_MFMA(PAF(3), VFR(3), o[2]), C1, 6); \
    KRD(GL, 4); GAPB(o[3] = ATA_MFMA(PAF(0), VFR(4), o[3]), C1, 8); \
    KRD(GL, 5); GAPB(o[3] = ATA_MFMA(PAF(1), VFR(5), o[3]), C1, 10); \
    KRD(GL, 6); GAPB(o[3] = ATA_MFMA(PAF(2), VFR(6), o[3]), C1, 12); \
    KRD(GL, 7); GAPB(o[3] = ATA_MFMA(PAF(3), VFR(7), o[3]), C1, 14); \
    } while (0)
    int t = 1;
#pragma unroll 1
    for (; t < NT - 3; t += 2) {
        STEP(pB0, pB1, pA0, pA1, t, true, true, true);     if (VAR == 3) { asm volatile("s_waitcnt lgkmcnt(0)" ::: "memory"); } else { ATA_WAIT_BAR(4); } ROT();
        STEP(pA0, pA1, pB0, pB1, t + 1, true, true, true); if (VAR == 3) { asm volatile("s_waitcnt lgkmcnt(0)" ::: "memory"); } else { ATA_WAIT_BAR(4); } ROT();
    }
    STEP(pB0, pB1, pA0, pA1, NT - 3, false, true, true);  ATA_WAIT_BAR(2); ROT();
    STEP(pA0, pA1, pB0, pB1, NT - 2, false, true, true);  ATA_WAIT_BAR(2); ROT();
    STEP(pB0, pB1, pA0, pA1, NT - 1, false, false, false); ATA_WAIT_BAR(0); ROT();
    { float sacc = 0.f;
#pragma unroll
      for (int r = 0; r < 16; ++r) sacc += pB0[r] + pB1[r];
      l_reg += sacc;
      pw0 = (u32x4){PKW(pB0, 0), PKW(pB0, 2), PKW(pB0, 4), PKW(pB0, 6)}; pw1 = (u32x4){PKW(pB0, 8), PKW(pB0, 10), PKW(pB0, 12), PKW(pB0, 14)};
      pw2 = (u32x4){PKW(pB1, 0), PKW(pB1, 2), PKW(pB1, 4), PKW(pB1, 6)}; pw3 = (u32x4){PKW(pB1, 8), PKW(pB1, 10), PKW(pB1, 12), PKW(pB1, 14)};
      const lds_cptr vpA_ = vpA + sl_prev, vpB_ = vpB + sl_prev;
#pragma unroll
      for (int d0 = 0; d0 < 4; ++d0) { const lds_cptr vb = ((d0 & 1) ? vpB_ : vpA_) + (d0 >> 1) * 8192;
          const s16x4 a0 = vtr(vb), b0 = vtr(vb + 1024), a1 = vtr(vb + 2048), b1 = vtr(vb + 3072);
          const s16x4 a2 = vtr(vb + 4096), b2 = vtr(vb + 5120), a3 = vtr(vb + 6144), b3 = vtr(vb + 7168);
#define VF2(a, b) (bf16x8){a[0], a[1], a[2], a[3], b[0], b[1], b[2], b[3]}
          o[d0] = ATA_MFMA(PAF(0), VF2(a0, b0), o[d0]); o[d0] = ATA_MFMA(PAF(1), VF2(a1, b1), o[d0]); o[d0] = ATA_MFMA(PAF(2), VF2(a2, b2), o[d0]); o[d0] = ATA_MFMA(PAF(3), VF2(a3, b3), o[d0]);
#undef VF2
      } }
    l_reg += __shfl_xor(l_reg, 32);
    if (hi == 0) wsf[r32] = l_reg;
    asm volatile("s_waitcnt lgkmcnt(0)\n\ts_barrier" ::: "memory");
    float rli[16];
#pragma unroll
    for (int r = 0; r < 16; ++r) rli[r] = 1.0f / wsf[crow(r, hi)];
    float* X = (float*)(shm + LDS_X) + wq * 4096;
    if (mp == 1) {
#pragma unroll
        for (int d0 = 0; d0 < 4; ++d0)
#pragma unroll
            for (int r = 0; r < 16; ++r) X[crow(r, hi) * 128 + d0 * 32 + r32] = o[d0][r] * rli[r];
    }
    asm volatile("s_waitcnt lgkmcnt(0)\n\ts_barrier" ::: "memory");
    if (mp == 0) {
        float ss[16];
#pragma unroll
        for (int r = 0; r < 16; ++r) ss[r] = 0.f;
#pragma unroll
        for (int d0 = 0; d0 < 4; ++d0)
#pragma unroll
            for (int r = 0; r < 16; ++r) { const float av = o[d0][r] * rli[r] - P.lam * X[crow(r, hi) * 128 + d0 * 32 + r32]; o[d0][r] = av; ss[r] += av * av; }
#pragma unroll
        for (int r = 0; r < 16; ++r) {
            float v = ss[r];
#pragma unroll
            for (int of = 1; of < 32; of <<= 1) v += __shfl_xor(v, of);
            ss[r] = P.one_minus_li / sqrtf(v * (1.0f / 128) + 1e-6f);
        }
        unsigned short* Ow = P.O + (rowbase + q0) * OP + h * 128;
#pragma unroll
        for (int d0 = 0; d0 < 4; ++d0) { const float gsub = P.subln[d0 * 32 + r32];
#pragma unroll
            for (int r = 0; r < 16; ++r) { const float y = o[d0][r] * ss[r] * gsub; unsigned u = __float_as_uint(y); u = (u + 0x7fffu + ((u >> 16) & 1u)) >> 16;
                Ow[(long)crow(r, hi) * OP + d0 * 32 + r32] = (unsigned short)u; } }
    }
    asm volatile("s_waitcnt lgkmcnt(0)\n\ts_barrier" ::: "memory");
#undef DMA_K
#undef DMA_V
#undef ROT
#undef PKW
#undef PAF
#undef VFR
#undef VOFF
#undef VRD
#undef EX
#undef GAPA
#undef GAPB
#undef KRD
#undef STEP
}
}
namespace atB {
using bf16x8 = __attribute__((ext_vector_type(8))) short;
using s16x4 = __attribute__((ext_vector_type(4))) short;
using f32x16 = __attribute__((ext_vector_type(16))) float;
using u32x4 = __attribute__((ext_vector_type(4))) unsigned;
typedef __attribute__((address_space(3))) const char* lds_cptr;
typedef short v4i16_t __attribute__((ext_vector_type(4)));
constexpr int S = 8192, QP = 768, LDS_K = 0, LDS_V = 49152;
__device__ __forceinline__ int crow(int r, int hi) { return (r & 3) + 8 * (r >> 2) + 4 * hi; }
__device__ __forceinline__ s16x4 vtr(lds_cptr p) { return __builtin_bit_cast(s16x4, __builtin_amdgcn_ds_read_tr16_b64_v4i16((__attribute__((address_space(3))) v4i16_t*)p)); }
__device__ __forceinline__ bf16x8 kld(lds_cptr p) { return *(const __attribute__((address_space(3))) bf16x8*)p; }
__device__ __forceinline__ unsigned cvtpk(float lo, float hi) { typedef float f2 __attribute__((ext_vector_type(2))); typedef __bf16 b2 __attribute__((ext_vector_type(2))); f2 v = {lo, hi}; b2 b = __builtin_convertvector(v, b2); return __builtin_bit_cast(unsigned, b); }
__device__ __forceinline__ void glds16(const void* gsrc, unsigned lds_dst) { unsigned keep;
    asm volatile("s_mov_b32 %0, m0\n\ts_mov_b32 m0, %2\n\ts_nop 0\n\tglobal_load_lds_dwordx4 %1, off\n\ts_mov_b32 m0, %0" : "=&s"(keep) : "v"(gsrc), "s"(lds_dst) : "memory"); }
struct Params { const unsigned short* Q; const unsigned short* K; const unsigned short* V; unsigned short* OG  ; float* LS  ; float negM; };

__device__ __forceinline__ void unit(const Params& P, int g, int b, int hh, int chunk32, char* shm, int wid) {
    int lane_; asm volatile("v_mbcnt_lo_u32_b32 %0, -1, 0\n\tv_mbcnt_hi_u32_b32 %0, -1, %0" : "=v"(lane_));
    const int lane = lane_, r32 = lane & 31, hi = lane >> 5;
    const int dil = g == 0 ? 1 : (g == 1 ? 4 : 16), L = S / dil, cps = 32 / dil;
    const int res = chunk32 / cps, t0 = 256 * (chunk32 % cps);
    const int hc = (g * 4 + hh) * 64;
    const size_t seq0 = (size_t)b * S + res;
    const unsigned lds0 = (unsigned)(uintptr_t)shm;
    { const int dsl = lane & 7;
#pragma unroll
      for (int i = 0; i < 6; ++i) { const int p = wid * 6 + i, kk = 8 * p + (lane >> 3); int tk = t0 - 64 + kk; tk = tk < 0 ? 0 : (tk > L - 1 ? L - 1 : tk);
          const size_t row = (seq0 + (size_t)tk * dil) * QP + hc;
          glds16(P.K + row + ((dsl ^ ((kk >> 1) & 7)) * 8), (unsigned)__builtin_amdgcn_readfirstlane(lds0 + LDS_K + p * 1024));
          glds16(P.V + row + (((dsl >> 2) ^ ((kk >> 1) & 1)) * 32) + (dsl & 3) * 8, (unsigned)__builtin_amdgcn_readfirstlane(lds0 + LDS_V + p * 1024)); } }
    bf16x8 qr[4];
    { const unsigned short* qp = P.Q + (seq0 + (size_t)(t0 + 32 * wid + r32) * dil) * QP + hc + hi * 8;
#pragma unroll
      for (int d0 = 0; d0 < 4; ++d0) qr[d0] = *reinterpret_cast<const bf16x8*>(qp + d0 * 16); }
    asm volatile("s_waitcnt vmcnt(0)\n\ts_barrier" ::: "memory");
    const lds_cptr shm3 = (lds_cptr)shm;
    lds_cptr kpd[4];
#pragma unroll
    for (int d0 = 0; d0 < 4; ++d0) kpd[d0] = shm3 + LDS_K + wid * 4096 + r32 * 128 + (((2 * d0 + hi) ^ ((r32 >> 1) & 7)) * 16);
    const int vq = (lane & 15) >> 2, vsq = (vq >> 1) & 1;
    const lds_cptr vpA = shm3 + LDS_V + wid * 4096 + ((lane >> 4) & 1) * 32 + (lane & 3) * 8 + (4 * hi + vq) * 128 + vsq * 64;
    const lds_cptr vpB = shm3 + LDS_V + wid * 4096 + ((lane >> 4) & 1) * 32 + (lane & 3) * 8 + (4 * hi + vq) * 128 + (vsq ^ 1) * 64;
    f32x16 o[2]; o[0] = f32x16{}; o[1] = f32x16{};
    float l_reg = 0.f;
    const int tq0 = t0 + 32 * wid;
#pragma unroll
    for (int j = 0; j < 5; ++j) {
        const int tk0 = tq0 - 64 + 32 * j;
        f32x16 c = __builtin_amdgcn_mfma_f32_32x32x16_bf16(kld(kpd[0] + j * 4096), qr[0], f32x16{}, 0, 0, 0);
#pragma unroll
        for (int d0 = 1; d0 < 4; ++d0) c = __builtin_amdgcn_mfma_f32_32x32x16_bf16(kld(kpd[d0] + j * 4096), qr[d0], c, 0, 0, 0);
        float sacc = 0.f;
#pragma unroll
        for (int r = 0; r < 16; ++r) { const int kk = crow(r, hi), tk = tk0 + kk, df = tk - (tq0 + r32);
            const bool ok = (df >= -64) && (df <= 64) && (tk >= 0) && (tk < L);
            const float p = ok ? __builtin_amdgcn_exp2f(c[r] + P.negM) : 0.f; c[r] = p; sacc += p; }
        l_reg += sacc;
        const u32x4 pw0 = (u32x4){cvtpk(c[0], c[1]), cvtpk(c[2], c[3]), cvtpk(c[4], c[5]), cvtpk(c[6], c[7])};
        const u32x4 pw1 = (u32x4){cvtpk(c[8], c[9]), cvtpk(c[10], c[11]), cvtpk(c[12], c[13]), cvtpk(c[14], c[15])};
#pragma unroll
        for (int db = 0; db < 2; ++db)
#pragma unroll
            for (int ks = 0; ks < 2; ++ks) { const lds_cptr vb = (db ? vpB : vpA) + j * 4096 + ks * 2048; const s16x4 lo_ = vtr(vb), hi_ = vtr(vb + 1024);
                const bf16x8 vf = (bf16x8){lo_[0], lo_[1], lo_[2], lo_[3], hi_[0], hi_[1], hi_[2], hi_[3]};
                o[db] = __builtin_amdgcn_mfma_f32_32x32x16_bf16(__builtin_bit_cast(bf16x8, ks == 0 ? pw0 : pw1), vf, o[db], 0, 0, 0); }
    }
    l_reg += __shfl_xor(l_reg, 32);
    if (hi == 0) P.LS[(seq0 + (size_t)(tq0 + r32) * dil) * 12 + g * 4 + hh] = l_reg;
#pragma unroll
    for (int db = 0; db < 2; ++db)
#pragma unroll
        for (int r = 0; r < 16; ++r) { unsigned u = __float_as_uint(o[db][r]); u = (u + 0x7fffu + ((u >> 16) & 1u)) >> 16;
            P.OG[((seq0 + (size_t)(tq0 + crow(r, hi)) * dil) * 3 + g) * 256 + hh * 64 + db * 32 + r32] = (unsigned short)u; }
    asm volatile("s_waitcnt lgkmcnt(0)\n\ts_barrier" ::: "memory");
}
}
namespace mk {
constexpr int PH_PRO = 0, PH_L0 = 1, PH_PER_LAYER = 10, PH_FINAL = PH_L0 + DEPTH * PH_PER_LAYER, PH_COUNT = PH_FINAL + 1;
enum { P_N1 = 0, P_G1, P_AT, P_CB, P_G2, P_G3, P_N2, P_G4, P_G5, P_PAD };
constexpr int FLAG_NO_COMBINE = 1;

__global__ void __launch_bounds__(NTHR, 2) mk_fwd(Args a) {
    extern __shared__ __attribute__((aligned(16))) unsigned char lds_raw[];
    LAS unsigned char* lds = (LAS unsigned char*)lds_raw;
    volatile LAS unsigned* MISC = (volatile LAS unsigned*)(lds + MISC_OFF);
    const int wave = __builtin_amdgcn_readfirstlane((int)threadIdx.x >> 6);

    const int G = gridDim.x, bx = blockIdx.x; const int vcu = (G % 8 == 0) ? (bx % 8) * (G / 8) + bx / 8 : bx;
    const int gw = vcu * NWAVES + wave, NGW = G * NWAVES;
    gu32* ctl = (gu32*)(a.ws + WS_CTL);
    { const int t0 = wave * 64 + lane_id(); if (t0 < 128) MISC[t0] = 0u; }
    __syncthreads();
    XcdBarrier bar = xcd_barrier_post((unsigned*)(ctl + CW_BAR) + a.bar_region * XCD_BAR_WORDS, MISC + 8);
    const int lo = a.ph_lo, hi = a.ph_hi;
#define IN(k) (lo <= (k) && (k) < hi)
#define SEAM(k) do { if (IN(k) && IN((k) + 1)) xcd_barrier(bar); } while (0)
    const float* mod = (const float*)(a.ws + WS_MOD);

    if (IN(PH_PRO)) { const int lane = lane_id(); prologue_small(a, lds, vcu, G, wave, lane, wave * 64 + lane); convert_layer(a, 0, lds, gw, NGW, wave, lane); }
    SEAM(PH_PRO);
#pragma unroll 1
    for (int l = 0; l < DEPTH; ++l) {
        const int pb = PH_L0 + l * PH_PER_LAYER;
        const float* modl = mod + (size_t)l * NB * 6 * D;
        if (IN(pb + P_N1)) {
            int lane_p = lane_id(), wave_p = wave; asm volatile("" : "+v"(lane_p), "+s"(wave_p));
            const int gw_p = vcu * NWAVES + wave_p;
            if (l > 0) { convert_layer(a, l, lds, gw_p, NGW, wave_p, lane_p);
                if (!(a.flags & FLAG_NO_COMBINE)) combine_rows(a.out, (const bf16*)(a.ws + WS_Y), modl - (size_t)NB * 6 * D, a.out, gw_p, NGW, lane_p); }
            norm_rows((l == 0 && !(a.flags & FLAG_NO_COMBINE)) ? a.xin : a.out, modl, 0, 1024, (bf16*)(a.ws + WS_H), gw_p, NGW, lane_p);
        }
        SEAM(pb + P_N1);
        if (IN(pb + P_G1)) {
            pg8::Gemm g{(const pg8::bf16_t*)(a.ws + WS_H), (const pg8::bf16_t*)(a.ws + WS_WIN), T, INW, D};
            pg8::StaticOrder So; So.init(T, INW, G, bx);
            EpiG1 E{a.ws, (const float*)(a.ws + WS_CS), (const float*)a.in[IN_QNA] + l * 64, (const float*)a.in[IN_KNA] + l * 64, (const float*)a.in[IN_QNB] + l * 64, (const float*)a.in[IN_KNB] + l * 64};
            pg8::gemm_phase<EpiG1, pg8::StaticOrder, true, true>(lds, g, So, E, wave);
        }
        SEAM(pb + P_G1);
        if (IN(pb + P_AT)) {
            const float* lw = mod + DEPTH * NB * 6 * D + 4 * l;
            { atB::Params PB{(const unsigned short*)(a.ws + WS_QB), (const unsigned short*)(a.ws + WS_KB), (const unsigned short*)(a.ws + WS_VB), (unsigned short*)(a.ws + WS_OG), (float*)(a.ws + WS_LS), lw[3]};
              for (int u = vcu; u < 768; u += G) { const int g = u >> 8, rem = u & 255; atB::unit(PB, g, rem >> 7, (rem >> 5) & 3, rem & 31, (char*)lds_raw, wave); }
              __syncthreads(); }
            atA::Params P{(const unsigned short*)(a.ws + WS_QA), (const unsigned short*)(a.ws + WS_KA), (const unsigned short*)(a.ws + WS_VA), (unsigned short*)(a.ws + WS_OUTAB),
                          lw[2], lw[0], 1.0f - lw[1], (const float*)a.in[IN_SUBLN] + l * 128};
            for (int u = vcu; u < 512; u += G) { const int bh = (u >> 5) & 7, qb = (u & 31) + 32 * (u >> 8); atA::unit<0>(P, bh >> 2, bh & 3, qb, (char*)lds_raw, wave); }
        }
        SEAM(pb + P_AT);
        if (IN(pb + P_G2)) {
            pg8::StaticOrder So; So.init(T, D, G, bx);
            { const unsigned short* OG = (const unsigned short*)(a.ws + WS_OG); const float* LS = (const float*)(a.ws + WS_LS); bf16* OB = (bf16*)(a.ws + WS_OUTAB) + 512;
              const int tid_p = wave * 64 + lane_id(); pg8::Unit u;
              for (int i = 0; So.next(i, u); ++i)
                  for (int it = tid_p; it < 256 * 32; it += NTHR) { const int t = u.pm * 256 + (it >> 5), c0 = (it & 31) * 8, hh = c0 >> 6;
                      float acc8[8] = {0.f, 0.f, 0.f, 0.f, 0.f, 0.f, 0.f, 0.f}; float ls = 0.f;
#pragma unroll
                      for (int g = 0; g < 3; ++g) { float f[8]; unpack8(*(const pg8::u32x4*)(OG + ((size_t)t * 3 + g) * 256 + c0), f); ls += LS[(size_t)t * 12 + g * 4 + hh];
#pragma unroll
                          for (int j = 0; j < 8; ++j) acc8[j] += f[j]; }
                      const float il = __builtin_amdgcn_rcpf(ls);
                      pg8::u32x4 w; w.x = pg8::cvt_pk_bf16(acc8[0] * il, acc8[1] * il); w.y = pg8::cvt_pk_bf16(acc8[2] * il, acc8[3] * il); w.z = pg8::cvt_pk_bf16(acc8[4] * il, acc8[5] * il); w.w = pg8::cvt_pk_bf16(acc8[6] * il, acc8[7] * il);
                      *(pg8::u32x4*)(OB + (size_t)t * 768 + c0) = w; }
              asm volatile("s_waitcnt vmcnt(0)" ::: "memory"); __syncthreads(); }
            pg8::Gemm g{(const pg8::bf16_t*)(a.ws + WS_OUTAB), (const pg8::bf16_t*)(a.ws + WS_WPAB), T, D, 768};
            EpiG2 E{(const bf16*)(a.ws + WS_GA), (const bf16*)(a.ws + WS_GB), (bf16*)(a.ws + WS_MG)};
            pg8::gemm_phase<EpiG2, pg8::StaticOrder, false, true>(lds, g, So, E, wave);
        }
        SEAM(pb + P_G2);
        if (IN(pb + P_G3)) {
            pg8::Gemm g{(const pg8::bf16_t*)(a.ws + WS_MG), (const pg8::bf16_t*)(a.ws + WS_WO), T, D, D};
            pg8::StaticOrder So; So.init(T, D, G, bx);
            EpiG3 E{(l == 0 && !(a.flags & FLAG_NO_COMBINE)) ? a.xin : a.out, a.out, modl + 2048};
            pg8::gemm_phase<EpiG3, pg8::StaticOrder, false, true>(lds, g, So, E, wave);
        }
        SEAM(pb + P_G3);
        if (IN(pb + P_N2)) { int lane_p = lane_id(), wave_p = wave; asm volatile("" : "+v"(lane_p), "+s"(wave_p));
            n2_rows(a, l, a.out, modl, lds, MISC, vcu, G, wave_p, lane_p); }
        SEAM(pb + P_N2);
        if (IN(pb + P_G4)) {
            moe_tables(a, l, MISC, wave, lane_id());
            pg8::Gemm g{(const pg8::bf16_t*)(a.ws + WS_H), (const pg8::bf16_t*)(a.ws + WS_WGU), T, NEXP * 512, D};
            MoeSched So{MISC, (const int*)(a.ws + WS_LIST), 2, G, bx, true};
            EpiG4 E{(bf16*)(a.ws + WS_HID), MISC};
            pg8::gemm_phase_g<EpiG4, MoeSched, false>(lds, g, So, E, wave);
        }
        SEAM(pb + P_G4);
        if (IN(pb + P_G5)) {
            moe_tables(a, l, MISC, wave, lane_id());
            pg8::Gemm g{(const pg8::bf16_t*)(a.ws + WS_HID), (const pg8::bf16_t*)(a.ws + WS_WDN), 40960, NEXP * D, DEXP};
            MoeSched So{MISC, (const int*)(a.ws + WS_LIST), 4, G, bx, false};
            EpiG5 E{(bf16*)(a.ws + WS_Y), (const int*)(a.ws + WS_LIST), (const float*)(a.ws + WS_RTW), MISC};
            pg8::gemm_phase<EpiG5, MoeSched, false, true>(lds, g, So, E, wave);
        }
        SEAM(pb + P_G5);
    }
#ifdef PROBE_VAR
    if (IN(41)) {
        const float* lw = mod + DEPTH * NB * 6 * D + 4;
        atB::Params PB{(const unsigned short*)(a.ws + WS_QB), (const unsigned short*)(a.ws + WS_KB), (const unsigned short*)(a.ws + WS_VB), (unsigned short*)(a.ws + WS_OG), (float*)(a.ws + WS_LS), lw[3]};
        for (int u = vcu; u < 768; u += G) { const int g = u >> 8, rem = u & 255; atB::unit(PB, g, rem >> 7, (rem >> 5) & 3, rem & 31, (char*)lds_raw, wave); }
    }
    if (IN(40)) {
        const float* lw = mod + DEPTH * NB * 6 * D + 4;
        atA::Params P{(const unsigned short*)(a.ws + WS_QA), (const unsigned short*)(a.ws + WS_KA), (const unsigned short*)(a.ws + WS_VA), (unsigned short*)(a.ws + WS_OUTAB),
                      lw[2], lw[0], 1.0f - lw[1], (const float*)a.in[IN_SUBLN] + 128};
        for (int u = vcu; u < 512; u += G) { const int bh = (u >> 5) & 7, qb = (u & 31) + 32 * (u >> 8); atA::unit<PROBE_VAR>(P, bh >> 2, bh & 3, qb, (char*)lds_raw, wave); }
    }
#endif
    if (IN(PH_FINAL)) { int lane_p = lane_id(), wave_p = wave; asm volatile("" : "+v"(lane_p), "+s"(wave_p));
        combine_rows(a.out, (const bf16*)(a.ws + WS_Y), mod + (size_t)(DEPTH - 1) * NB * 6 * D, a.out, vcu * NWAVES + wave_p, NGW, lane_p); }
#undef IN
#undef SEAM
}
}
extern "C" void kernel_launch(void* const* d_in, const int* in_sizes, int n_in, void* d_out, int out_size, void* d_ws, size_t ws_size, hipStream_t stream) {
    using namespace mk;
    const float* x = (const float*)d_in[0];
    float* X = (float*)d_out;
    unsigned char* ws = (unsigned char*)d_ws;
    static int grid = 0;
    if (grid == 0) {
        int dev = 0, cus = 0;
        if (hipGetDevice(&dev) != hipSuccess || hipDeviceGetAttribute(&cus, hipDeviceAttributeMultiprocessorCount, dev) != hipSuccess) { fprintf(stderr, "device query failed\n"); grid = -1; return; }
        if (hipFuncSetAttribute((const void*)mk::mk_fwd, hipFuncAttributeMaxDynamicSharedMemorySize, mk::LDS_BYTES) != hipSuccess) { fprintf(stderr, "hipFuncSetAttribute failed\n"); grid = -1; return; }
        int per_cu = 0;
        if (hipOccupancyMaxActiveBlocksPerMultiprocessor(&per_cu, (const void*)mk::mk_fwd, mk::NTHR, mk::LDS_BYTES) != hipSuccess || per_cu < 1) { fprintf(stderr, "occupancy query says %d\n", per_cu); }
        (void)hipGetLastError();
        if (mk::WS_END > ws_size) { fprintf(stderr, "workspace too small: need %zu have %zu\n", (size_t)mk::WS_END, ws_size); grid = -1; return; }
        grid = cus;
    }
    if (grid < 0) return;

    hipMemsetAsync(ws + mk::WS_CTL, 0, mk::CTL_ZERO_BYTES, stream);
    mk::Args a{};
    for (int i = 0; i < 25; ++i) a.in[i] = d_in[i];
    a.out = X; a.ws = ws; a.xin = x; a.flags = 0;
    int region = 0;
    auto fast = [&](int lo, int hi) { a.ph_lo = lo; a.ph_hi = hi; a.bar_region = region++; hipLaunchKernelGGL(mk::mk_fwd, dim3(grid), dim3(mk::NTHR), mk::LDS_BYTES, stream, a); };

    fast(0, mk::PH_FINAL + 1);
#ifdef PROBE_LO
    fast(PROBE_LO, PROBE_HI);
#endif
}
```
